# Optimizing an MI355X kernel written in HIP

```python
import math
import jax
import jax.numpy as jnp
from jax import lax
import numpy as np

D_MODEL = 1024
BATCH = 1
SEQ = 16384
DEPTH = 4
DEC_BATCH = 16
DEC_SEQ = 4096
PAST_LEN = 128

HC = D_MODEL // 2
HYENA_ORDER = 2
FILTER_EMB = 33
FILTER_BANDS = (FILTER_EMB - 1) // 2
FILTER_HIDDEN = 64
DECAY_TARGET = 1e-2
FAST_DECAY_PCT = 0.3
SLOW_DECAY_PCT = 1.5
DECAY_SHIFT = 0.05
SHORT_CONV = 3
B_HEAD_DIM = 64
B_HEADS = (D_MODEL // 2) // B_HEAD_DIM
B_KV_HEADS = 2
B_GROUP = B_HEADS // B_KV_HEADS
B_WIDTH = B_HEADS * B_HEAD_DIM
B_KV_WIDTH = B_KV_HEADS * B_HEAD_DIM
B_WINDOW = 128
B_BLOCK = 128
C_PATTERNS = ((128, 1), (512, 4), (2048, 16))
N_PAT = len(C_PATTERNS)
C_HEADS = 8
C_HEAD_DIM = D_MODEL // C_HEADS
C_WIDTH = C_HEADS * C_HEAD_DIM
C_BLOCK = 64
ROPE_THETA = 500000.0
ROPE_FRACTION = 4
NORM_EPS = 1e-6
NEG_INF = -1e30
EVEN_IN = 4 * HC + 2 * B_WIDTH + 2 * B_KV_WIDTH
EVEN_INNER = HC + B_WIDTH
ODD_IN = N_PAT * 3 * C_WIDTH + C_WIDTH
N_EVEN = (DEPTH + 1) // 2
N_ODD = DEPTH // 2

kernel_name = "hybrid_hyena_swa_dilated_encoder"


def rmsnorm(x, g):
    xf = x.astype(jnp.float32)
    y = xf * jax.lax.rsqrt(jnp.mean(xf * xf, axis=-1, keepdims=True) + NORM_EPS)
    return (y * g.astype(jnp.float32)).astype(x.dtype)


def rope(x, pos):
    hd = x.shape[-1]
    rot = hd // ROPE_FRACTION
    half = rot // 2
    inv = jnp.power(ROPE_THETA, -2.0 * jnp.arange(half, dtype=jnp.float32) / rot)
    ang = pos.astype(jnp.float32)[:, None] * inv[None, :]
    cos = jnp.cos(ang)[:, None, :]
    sin = jnp.sin(ang)[:, None, :]
    xf = x.astype(jnp.float32)
    x1, x2 = xf[..., :half], xf[..., half:rot]
    out = jnp.concatenate([x1 * cos - x2 * sin, x2 * cos + x1 * sin, xf[..., rot:]], axis=-1)
    return out.astype(x.dtype)


def short_conv(u, w, b):
    up = jnp.pad(u, ((0, 0), (1, 1), (0, 0)))
    return up[:, :-2] * w[0] + up[:, 1:-1] * w[1] + up[:, 2:] * w[2] + b


def hyena_filter_spectrum(L, w1, b1, f1, w2, b2, f2, w3):
    f32 = jnp.float32
    t = jnp.linspace(0.0, 1.0, L, dtype=f32)[:, None]
    wpos = 2.0 * math.pi * jnp.arange(L, dtype=f32)[:, None] / L
    bands = jnp.linspace(1e-4, FILTER_BANDS - 1, FILTER_BANDS, dtype=f32)[None, :]
    feats = jnp.concatenate([t, jnp.cos(bands * wpos), -jnp.sin(bands * wpos)], axis=-1)
    h = jnp.sin(f1.astype(f32) * (feats @ w1.astype(f32) + b1.astype(f32)))
    h = jnp.sin(f2.astype(f32) * (h @ w2.astype(f32) + b2.astype(f32)))
    h = (h @ w3.astype(f32)).reshape(L, HYENA_ORDER, 2, HC)
    max_decay = math.log(DECAY_TARGET) / FAST_DECAY_PCT
    min_decay = math.log(DECAY_TARGET) / SLOW_DECAY_PCT
    deltas = jnp.abs(jnp.linspace(min_decay, max_decay, HC, dtype=f32))
    window = jnp.exp(-t * deltas[None, :]) + DECAY_SHIFT
    h = h * window[:, None, None, :]
    fwd, bwd = h[:, :, 0], h[:, :, 1]
    filt = jnp.concatenate([fwd[:1] + bwd[:1], fwd[1:], jnp.zeros_like(fwd[:1]), bwd[1:][::-1]], axis=0)
    return jnp.fft.rfft(filt, axis=0)


def hyena_mix(u, spec, hyena_d):
    L = u.shape[1]
    x1, x2, z = jnp.split(u.astype(jnp.float32), 3, axis=-1)
    gates = (x1, x2)
    for o in range(HYENA_ORDER):
        zf = jnp.fft.rfft(z, n=2 * L, axis=1)
        conv = jnp.fft.irfft(zf * spec[None, :, o, :], n=2 * L, axis=1)[:, :L]
        z = gates[o] * (conv + hyena_d[o].astype(jnp.float32) * z)
    return z.astype(u.dtype)


def band_attention(q, k, v, radius, block, n_valid, sink=None):
    B, L, Hk, G, hd = q.shape
    nb = L // block
    qb = q.reshape(B, nb, block, Hk, G, hd)
    pad = ((0, 0), (block, block), (0, 0), (0, 0))
    kp = jnp.pad(k, pad).reshape(B, nb + 2, block, Hk, hd)
    vp = jnp.pad(v, pad).reshape(B, nb + 2, block, Hk, hd)
    kw = jnp.concatenate([kp[:, :-2], kp[:, 1:-1], kp[:, 2:]], axis=2)
    vw = jnp.concatenate([vp[:, :-2], vp[:, 1:-1], vp[:, 2:]], axis=2).astype(jnp.float32)
    qpos = jnp.arange(L).reshape(nb, block)
    kpos = jnp.arange(nb)[:, None] * block - block + jnp.arange(3 * block)[None, :]
    rel = kpos[:, None, :] - qpos[:, :, None]
    valid = (jnp.abs(rel) <= radius) & (kpos[:, None, :] >= 0) & (kpos[:, None, :] < n_valid)
    s = jnp.einsum('bnqhgd,bnkhd->bnhgqk', qb, kw, preferred_element_type=jnp.float32) * (hd ** -0.5)
    s = jnp.where(valid[None, :, None, None], s, NEG_INF)
    m = jnp.max(s, axis=-1)
    if sink is not None:
        sink_b = sink.astype(jnp.float32).reshape(1, 1, Hk, G, 1)
        m = jnp.maximum(m, sink_b)
    p = jnp.exp(s - m[..., None])
    denom = jnp.sum(p, axis=-1)
    if sink is not None:
        denom = denom + jnp.exp(sink_b - m)
    o = jnp.einsum('bnhgqk,bnkhd->bnqhgd', p, vw)
    o = o / jnp.transpose(denom, (0, 1, 4, 2, 3))[..., None]
    lse = jnp.transpose(m + jnp.log(denom), (0, 1, 4, 2, 3)).reshape(B, L, Hk, G)
    return o.reshape(B, L, Hk, G, hd).astype(q.dtype), lse


def dilated_attention(q, k, v, window, dilation):
    B, L, H, hd = q.shape
    radius = window // (2 * dilation)
    Ls = L // dilation
    Lp = -(-Ls // C_BLOCK) * C_BLOCK

    def strided(t):
        t = t.reshape(B, Ls, dilation, H, hd).swapaxes(1, 2).reshape(B * dilation, Ls, H, hd)
        return jnp.pad(t, ((0, 0), (0, Lp - Ls), (0, 0), (0, 0)))

    o, lse = band_attention(strided(q)[:, :, :, None], strided(k), strided(v), radius, C_BLOCK, Ls)
    o = o[:, :Ls, :, 0].reshape(B, dilation, Ls, H, hd).swapaxes(1, 2).reshape(B, L, H, hd)
    lse = lse[:, :Ls, :, 0].reshape(B, dilation, Ls, H).swapaxes(1, 2).reshape(B, L, H)
    return o, lse


def hybrid_layer(x, norm_g, w_in, conv_w, conv_b, fw1, fb1, ff1, fw2, fb2, ff2, fw3, hyena_d, sink, w_out):
    B, L, _ = x.shape
    pos = jnp.arange(L)
    proj = rmsnorm(x, norm_g) @ w_in
    cuts = [3 * HC, 4 * HC, 4 * HC + B_WIDTH, 4 * HC + B_WIDTH + B_KV_WIDTH,
            4 * HC + B_WIDTH + 2 * B_KV_WIDTH]
    hy_in, hy_gate, q, k, v, at_gate = jnp.split(proj, cuts, axis=-1)
    spec = hyena_filter_spectrum(L, fw1, fb1, ff1, fw2, fb2, ff2, fw3)
    hy = hyena_mix(short_conv(hy_in, conv_w, conv_b), spec, hyena_d)
    q = rope(q.reshape(B, L, B_HEADS, B_HEAD_DIM), pos).reshape(B, L, B_KV_HEADS, B_GROUP, B_HEAD_DIM)
    k = rope(k.reshape(B, L, B_KV_HEADS, B_HEAD_DIM), pos)
    v = v.reshape(B, L, B_KV_HEADS, B_HEAD_DIM)
    at, _ = band_attention(q, k, v, B_WINDOW, B_BLOCK, L, sink)
    mixed = jnp.concatenate([hy * jax.nn.silu(hy_gate),
                             at.reshape(B, L, B_WIDTH) * jax.nn.silu(at_gate)], axis=-1)
    return x + mixed @ w_out


def dilated_layer(x, norm_g, w_in, w_out):
    B, L, _ = x.shape
    pos = jnp.arange(L)
    proj = rmsnorm(x, norm_g) @ w_in
    qkv = proj[..., :N_PAT * 3 * C_WIDTH].reshape(B, L, N_PAT, 3, C_HEADS, C_HEAD_DIM)
    gate = proj[..., N_PAT * 3 * C_WIDTH:]
    outs, lses = [], []
    for g, (window, dilation) in enumerate(C_PATTERNS):
        q = rope(qkv[:, :, g, 0], pos)
        k = rope(qkv[:, :, g, 1], pos)
        o, lse = dilated_attention(q, k, qkv[:, :, g, 2], window, dilation)
        outs.append(o)
        lses.append(lse)
    alpha = jax.nn.softmax(jnp.stack(lses), axis=0)
    o = jnp.einsum('pblh,pblhd->blhd', alpha, jnp.stack(outs).astype(jnp.float32))
    y = o.reshape(B, L, C_WIDTH).astype(x.dtype) * jax.nn.silu(gate)
    return x + y @ w_out


def trunk(x, a_norm, a_w_in, a_conv_w, a_conv_b, a_filt_w1, a_filt_b1, a_filt_f1, a_filt_w2,
          a_filt_b2, a_filt_f2, a_filt_w3, a_hyena_d, a_sink, a_w_out, c_norm, c_w_in, c_w_out,
          final_norm):
    for layer in range(DEPTH):
        i = layer // 2
        if layer % 2 == 0:
            x = hybrid_layer(x, a_norm[i], a_w_in[i], a_conv_w[i], a_conv_b[i], a_filt_w1[i],
                             a_filt_b1[i], a_filt_f1[i], a_filt_w2[i], a_filt_b2[i], a_filt_f2[i],
                             a_filt_w3[i], a_hyena_d[i], a_sink[i], a_w_out[i])
        else:
            x = dilated_layer(x, c_norm[i], c_w_in[i], c_w_out[i])
    return rmsnorm(x, final_norm)


def setup_inputs(seed: int = 0) -> dict:
    key = jax.random.key(seed)
    ks = jax.random.split(key, 20)
    f32 = jnp.float32

    def nrm(k, shape, scale):
        return scale * jax.random.normal(k, shape, f32)

    return {
        "x_prompt": nrm(ks[0], (BATCH, SEQ, D_MODEL), 1.0),
        "x_sample": nrm(ks[1], (DEC_BATCH, DEC_SEQ, D_MODEL), 1.0),
        "a_norm": 1.0 + nrm(ks[2], (N_EVEN, D_MODEL), 0.05),
        "a_w_in": nrm(ks[3], (N_EVEN, D_MODEL, EVEN_IN), D_MODEL ** -0.5),
        "a_conv_w": nrm(ks[4], (N_EVEN, SHORT_CONV, 3 * HC), SHORT_CONV ** -0.5),
        "a_conv_b": nrm(ks[5], (N_EVEN, 3 * HC), 0.02),
        "a_filt_w1": nrm(ks[6], (N_EVEN, FILTER_EMB, FILTER_HIDDEN), FILTER_EMB ** -0.5),
        "a_filt_b1": nrm(ks[7], (N_EVEN, FILTER_HIDDEN), 0.1),
        "a_filt_f1": 1.0 + nrm(ks[8], (N_EVEN, FILTER_HIDDEN), 0.01),
        "a_filt_w2": nrm(ks[9], (N_EVEN, FILTER_HIDDEN, FILTER_HIDDEN), FILTER_HIDDEN ** -0.5),
        "a_filt_b2": nrm(ks[10], (N_EVEN, FILTER_HIDDEN), 0.1),
        "a_filt_f2": 1.0 + nrm(ks[11], (N_EVEN, FILTER_HIDDEN), 0.01),
        "a_filt_w3": nrm(ks[12], (N_EVEN, FILTER_HIDDEN, HYENA_ORDER * 2 * HC), 0.03 * FILTER_HIDDEN ** -0.5),
        "a_hyena_d": nrm(ks[13], (N_EVEN, HYENA_ORDER, HC), 0.5),
        "a_sink": nrm(ks[14], (N_EVEN, B_HEADS), 0.5),
        "a_w_out": nrm(ks[15], (N_EVEN, EVEN_INNER, D_MODEL), 0.5 * EVEN_INNER ** -0.5),
        "c_norm": 1.0 + nrm(ks[16], (N_ODD, D_MODEL), 0.05),
        "c_w_in": nrm(ks[17], (N_ODD, D_MODEL, ODD_IN), D_MODEL ** -0.5),
        "c_w_out": nrm(ks[18], (N_ODD, C_WIDTH, D_MODEL), 0.5 * C_WIDTH ** -0.5),
        "final_norm": 1.0 + nrm(ks[19], (D_MODEL,), 0.05),
    }


def reference(x_prompt, x_sample, a_norm, a_w_in, a_conv_w, a_conv_b, a_filt_w1, a_filt_b1, a_filt_f1,
              a_filt_w2, a_filt_b2, a_filt_f2, a_filt_w3, a_hyena_d, a_sink, a_w_out, c_norm, c_w_in,
              c_w_out, final_norm):
    y_prompt = trunk(x_prompt, a_norm, a_w_in, a_conv_w, a_conv_b, a_filt_w1, a_filt_b1, a_filt_f1,
                     a_filt_w2, a_filt_b2, a_filt_f2, a_filt_w3, a_hyena_d, a_sink, a_w_out, c_norm,
                     c_w_in, c_w_out, final_norm)
    y_sample = trunk(x_sample, a_norm, a_w_in, a_conv_w, a_conv_b, a_filt_w1, a_filt_b1, a_filt_f1,
                     a_filt_w2, a_filt_b2, a_filt_f2, a_filt_w3, a_hyena_d, a_sink, a_w_out, c_norm,
                     c_w_in, c_w_out, final_norm)
    return (y_prompt, y_sample)
```

```cpp
#include <hip/hip_runtime.h>
#include <hip/hip_cooperative_groups.h>
#include <cstdio>
namespace cg = cooperative_groups;

typedef __attribute__((ext_vector_type(8))) short bf16x8;
typedef __attribute__((ext_vector_type(16))) float f32x16;
typedef __attribute__((ext_vector_type(4))) float f32x4;
typedef __attribute__((ext_vector_type(4))) unsigned u32x4;
typedef __attribute__((ext_vector_type(2))) unsigned u32x2;
typedef unsigned short bf16_t;

#define DI __device__ __forceinline__
#define MFMA32(a, b, c) __builtin_amdgcn_mfma_f32_32x32x16_bf16((a), (b), (c), 0, 0, 0)

#ifndef REP_GIN
#define REP_GIN 1
#endif
#ifndef REP_HY
#define REP_HY 1
#endif
#ifndef REP_ATT
#define REP_ATT 1
#endif
#ifndef REP_FILT
#define REP_FILT 1
#endif
#ifndef MULTI_LAUNCH
#define MULTI_LAUNCH 0
#endif

static constexpr int NT = 81920;
static constexpr int CH = 16384;
static constexpr int NPH = 32;
static constexpr float LOG2E = 1.4426950408889634f;
static constexpr int HID_PER_LAYER = 64 * 16384 + 64 * 4096;

static constexpr size_t U_OFF = 0;
static constexpr size_t HG_OFF = U_OFF + (size_t)1536 * NT * 2;
static constexpr size_t Q_OFF = HG_OFF + (size_t)512 * NT * 2;
static constexpr size_t K_OFF = Q_OFF + (size_t)NT * 512 * 2;
static constexpr size_t VT_OFF = K_OFF + (size_t)NT * 128 * 2;
static constexpr size_t AG_OFF = VT_OFF + (size_t)128 * NT * 2;
static constexpr size_t GSTR_P = 2 * 16384 + 8;
static constexpr size_t GSTR_S = 2 * 4096 + 8;
static constexpr size_t GAP_OFF = AG_OFF + (size_t)NT * 512 * 2;
static constexpr size_t GBP_OFF = GAP_OFF + (size_t)1024 * GSTR_P * 2;
static constexpr size_t GAS_OFF = GBP_OFF + (size_t)1024 * GSTR_P * 2;
static constexpr size_t GBS_OFF = GAS_OFF + (size_t)1024 * GSTR_S * 2;
static constexpr size_t MIX_OFF = (GBS_OFF + (size_t)1024 * GSTR_S * 2 + 255) & ~(size_t)255;
static constexpr size_t ATO_OFF = MIX_OFF + (size_t)512 * NT * 2;
static constexpr size_t XBE_OFF = MIX_OFF;
static constexpr size_t EVEN_END = MIX_OFF + (size_t)NT * 1024 * 2;
static constexpr size_t XB_OFF = 0;
static constexpr size_t QO_OFF = (size_t)NT * 1024 * 2;
static constexpr size_t KO_OFF = QO_OFF + (size_t)3 * CH * 1024 * 2;
static constexpr size_t VTO_OFF = KO_OFF + (size_t)3 * CH * 1024 * 2;
static constexpr size_t GO_OFF = VTO_OFF + (size_t)3 * CH * 1024 * 2;
static constexpr size_t OG_OFF = GO_OFF + (size_t)2 * CH * 1024 * 2;
static constexpr size_t LSE_OFF = OG_OFF + (size_t)3 * CH * 1024 * 2;
static constexpr size_t Y_OFF = LSE_OFF + (size_t)3 * CH * 8 * 4;
static constexpr size_t ODD_END = Y_OFF + (size_t)CH * 1024 * 2;

struct Params {
  const float *xp, *xs;
  const float *a_norm, *a_w_in, *a_conv_w, *a_conv_b, *fw1, *fb1, *ff1, *fw2, *fb2, *ff2, *fw3, *hyd, *sink, *a_w_out;
  const float *c_norm, *c_w_in, *c_w_out, *final_norm;
  float* out;
  bf16_t *wt_ain, *wt_cin, *wt_aout, *wt_cout;
  float* hid;
  char* R;
  unsigned* bar;
};

DI unsigned short f2bf(float x) { unsigned u = __float_as_uint(x); u += 0x7fffu + ((u >> 16) & 1u); return (unsigned short)(u >> 16); }
DI float bf2f(unsigned short b) { return __uint_as_float(((unsigned)b) << 16); }
DI unsigned pack2(float a, float b) { unsigned r; asm("v_cvt_pk_bf16_f32 %0, %1, %2" : "=v"(r) : "v"(a), "v"(b)); return r; }
DI float bflo(unsigned w) { return __uint_as_float(w << 16); }
DI float bfhi(unsigned w) { return __uint_as_float(w & 0xffff0000u); }
typedef __attribute__((ext_vector_type(2))) __bf16 bf2_t;
DI float dot2sq(unsigned w, float c) { const bf2_t v = __builtin_bit_cast(bf2_t, w); return __builtin_amdgcn_fdot2_f32_bf16(v, v, c, false); }
DI float xhalf_max(float x) { const unsigned u = __float_as_uint(x); auto r = __builtin_amdgcn_permlane32_swap(u, u, false, false); return fmaxf(__uint_as_float(r[0]), __uint_as_float(r[1])); }
DI int otid() { int t = threadIdx.x; asm volatile("" : "+v"(t)); return t; }
DI int obid() { int t = blockIdx.x; asm volatile("" : "+s"(t)); return t; }
DI int seq_start_of(int tok) { return tok < 16384 ? 0 : (16384 + ((tok - 16384) & ~4095)); }
DI float silu(float x) { return x / (1.f + __expf(-x)); }
DI void store4bf(bf16_t* dst, const float (&v)[4]) { u32x2 w; w[0] = pack2(v[0], v[1]); w[1] = pack2(v[2], v[3]); *(u32x2*)dst = w; }


#define XB_TMO      128
#define XB_XCNT(j)  (256  + 64 * (j))
#define XB_XSUB(j)  (1280 + 64 * (j))
#define XB_XGEN(j)  (2304 + 64 * (j))
#define XB_TOP      3328
#define XB_TOPGEN   3392
#define XCD_BAR_WORDS 3456
#define XB_SPIN_CAP (1u << 22)
#define LAS __attribute__((address_space(3)))
DI unsigned xb_ld(unsigned* p) { return __hip_atomic_load(p, __ATOMIC_RELAXED, __HIP_MEMORY_SCOPE_AGENT); }
DI unsigned xb_add(unsigned* p, unsigned v) { return __hip_atomic_fetch_add(p, v, __ATOMIC_RELAXED, __HIP_MEMORY_SCOPE_AGENT); }
DI unsigned xb_xcc_id() { return (unsigned)__builtin_amdgcn_s_getreg((3 << 11) | 20) & 0xFu; }
#define XB_SPIN(cond, bar) do { unsigned _sp = 0; while (cond) { __builtin_amdgcn_s_sleep(1); \
    if ((++_sp & 255u) == 0u) { if (xb_ld(&(bar)[XB_TMO])) break; if (_sp > XB_SPIN_CAP) { atomicAdd(&(bar)[XB_TMO], 1u); break; } } } } while (0)
struct XcdBarrier { unsigned* bar; unsigned x; volatile LAS unsigned* st; };
DI XcdBarrier xcd_barrier_post(unsigned* bar, volatile LAS unsigned* st) {
  XcdBarrier b; b.bar = bar; b.x = xb_xcc_id(); b.st = st;
  if (threadIdx.x == 0) (void)xb_add(&bar[XB_XCNT(b.x)], 1u);
  return b;
}
DI void xcd_barrier_complete(unsigned* bar, unsigned x, unsigned& nloc, unsigned& nx) {
  const unsigned G = gridDim.x * gridDim.y * gridDim.z;
  unsigned sum, cnt, mine, sp = 0u;
  for (;;) {
    sum = 0u; cnt = 0u; mine = 0u;
#pragma unroll
    for (unsigned j = 0; j < 16; ++j) { const unsigned c = xb_ld(&bar[XB_XCNT(j)]); sum += c; cnt += (c > 0u) ? 1u : 0u; mine = (j == x) ? c : mine; }
    if (sum == G) break;
    __builtin_amdgcn_s_sleep(1);
    if ((++sp & 255u) == 0u) { if (xb_ld(&bar[XB_TMO])) break; if (sp > XB_SPIN_CAP) { atomicAdd(&bar[XB_TMO], 1u); break; } }
  }
  nloc = mine > 0u ? mine : 1u; nx = cnt > 0u ? cnt : 1u;
}
DI void xcd_barrier(const XcdBarrier& b) {
  asm volatile("s_waitcnt vmcnt(0)" ::: "memory");
  __syncthreads();
  if (threadIdx.x == 0) {
    unsigned* bar = b.bar;
    __builtin_amdgcn_s_waitcnt(0);
    unsigned nloc = b.st[0], nx = b.st[1];
    if (nloc == 0u) { xcd_barrier_complete(bar, b.x, nloc, nx); b.st[0] = nloc; b.st[1] = nx; }
    const unsigned old = xb_add(&bar[XB_XSUB(b.x)], 1u);
    const unsigned gen = old / nloc;
    if (old + 1u == (gen + 1u) * nloc) {
      __builtin_amdgcn_fence(__ATOMIC_RELEASE, "agent");
      asm volatile("s_waitcnt vmcnt(0)" ::: "memory");
      const unsigned og = xb_add(&bar[XB_TOP], 1u);
      const unsigned tg = og / nx;
      if (og + 1u == (tg + 1u) * nx) xb_add(&bar[XB_TOPGEN], 1u);
      else XB_SPIN(xb_ld(&bar[XB_TOPGEN]) == tg, bar);
      __builtin_amdgcn_fence(__ATOMIC_ACQUIRE, "agent");
      xb_add(&bar[XB_XGEN(b.x)], 1u);
      asm volatile("s_waitcnt vmcnt(0)" ::: "memory");
    } else {
      XB_SPIN(xb_ld(&bar[XB_XGEN(b.x)]) == gen, bar);
      __builtin_amdgcn_fence(__ATOMIC_ACQUIRE, "agent");
      asm volatile("s_waitcnt vmcnt(0)" ::: "memory");
    }
  }
  __syncthreads();
}

DI void prep_phase(const Params& p, char* smem) {
  const int tid = threadIdx.x;
  for (int m = 0; m < 8; ++m) {
    const float* W; const float* g = nullptr; bf16_t* Wt; int N;
    const int i = m & 1;
    if (m < 2) { N = 3328; W = p.a_w_in + (size_t)i * 1024 * 3328; g = p.a_norm + i * 1024; Wt = p.wt_ain + (size_t)i * 3328 * 1024; }
    else if (m < 4) { N = 10240; W = p.c_w_in + (size_t)i * 1024 * 10240; g = p.c_norm + i * 1024; Wt = p.wt_cin + (size_t)i * 10240 * 1024; }
    else if (m < 6) { N = 1024; W = p.a_w_out + (size_t)i * 1024 * 1024; Wt = p.wt_aout + (size_t)i * 1024 * 1024; }
    else { N = 1024; W = p.c_w_out + (size_t)i * 1024 * 1024; Wt = p.wt_cout + (size_t)i * 1024 * 1024; }
    const int items = N * 128;
    for (int it = blockIdx.x * 256 + tid; it < items; it += gridDim.x * 256) {
      const int n = it % N, kg = it / N;
      float v[8];
#pragma unroll
      for (int j = 0; j < 8; ++j) { const int k = kg * 8 + j; v[j] = W[(size_t)k * N + n] * (g ? g[k] : 1.f); }
      u32x4 w; w[0] = pack2(v[0], v[1]); w[1] = pack2(v[2], v[3]); w[2] = pack2(v[4], v[5]); w[3] = pack2(v[6], v[7]);
      *(u32x4*)(Wt + (size_t)n * 1024 + kg * 8) = w;
    }
  }
  {
    bf16_t* xbe = (bf16_t*)(p.R + XBE_OFF);
    for (int it = blockIdx.x * 256 + tid; it < NT * 128; it += gridDim.x * 256) {
      const size_t e = (size_t)it * 8;
      const float* src = e < (size_t)16384 * 1024 ? p.xp + e : p.xs + (e - (size_t)16384 * 1024);
      const float4 a = *(const float4*)src, b = *(const float4*)(src + 4);
      u32x4 w; w[0] = pack2(a.x, a.y); w[1] = pack2(a.z, a.w); w[2] = pack2(b.x, b.y); w[3] = pack2(b.z, b.w);
      *(u32x4*)(xbe + e) = w;
    }
  }
  float* sF = (float*)smem;
  float* sH = sF + 4 * 36;
  const int tl = tid >> 6, j = tid & 63;
  for (int item = blockIdx.x; item < 2 * 20480 / 4; item += gridDim.x) {
    const int gt = item * 4 + tl;
    const int li = gt / 20480, rem = gt % 20480;
    const int Lidx = rem >= 16384 ? 1 : 0;
    const int t = Lidx ? rem - 16384 : rem;
    const int L = Lidx ? 4096 : 16384;
    if (j < 33) {
      float f;
      if (j == 0) f = (float)t / (float)(L - 1);
      else {
        const int b = (j - 1) & 15;
        const float band = 1e-4f + (float)b * ((15.f - 1e-4f) / 15.f);
        const float wpos = 6.283185307179586f * (float)t / (float)L;
        const float a = band * wpos;
        f = (j <= 16) ? cosf(a) : -sinf(a);
      }
      sF[tl * 36 + j] = f;
    }
    __syncthreads();
    {
      const float* w1 = p.fw1 + li * 33 * 64;
      float a = p.fb1[li * 64 + j];
      for (int e = 0; e < 33; ++e) a += sF[tl * 36 + e] * w1[e * 64 + j];
      sH[tl * 64 + j] = sinf(p.ff1[li * 64 + j] * a);
    }
    __syncthreads();
    {
      const float* w2 = p.fw2 + li * 64 * 64;
      float a = p.fb2[li * 64 + j];
      for (int e = 0; e < 64; ++e) a += sH[tl * 64 + e] * w2[e * 64 + j];
      const float h2 = sinf(p.ff2[li * 64 + j] * a);
      p.hid[(size_t)li * HID_PER_LAYER + (Lidx ? 64 * 16384 : 0) + (size_t)j * L + t] = h2;
    }
    __syncthreads();
  }
}

DI void filt_job(const Params& p, int li, int Lidx, int o, int cg, int tch, char* smem) {
  const int tid = otid();
  const int L = Lidx ? 4096 : 16384;
  const int c0 = cg * 16;
  const float* hid = p.hid + (size_t)li * HID_PER_LAYER + (Lidx ? 64 * 16384 : 0);
  const float* w3 = p.fw3 + (size_t)li * 64 * 2048;
  float* sW = (float*)smem;
  __syncthreads();
  for (int e = tid; e < 64 * 32; e += 256) {
    const int jj = e >> 5, cc = e & 31;
    sW[e] = w3[jj * 2048 + (o * 2 + (cc >> 4)) * 512 + c0 + (cc & 15)];
  }
  __syncthreads();
  const int t = tch * 256 + tid;
  float acc[32];
#pragma unroll
  for (int i = 0; i < 32; ++i) acc[i] = 0.f;
#pragma unroll 4
  for (int jj = 0; jj < 64; ++jj) {
    const float hv = hid[(size_t)jj * L + t];
#pragma unroll
    for (int q = 0; q < 8; ++q) {
      const float4 w = *(const float4*)(sW + jj * 32 + 4 * q);
      acc[4 * q + 0] += hv * w.x; acc[4 * q + 1] += hv * w.y; acc[4 * q + 2] += hv * w.z; acc[4 * q + 3] += hv * w.w;
    }
  }
  const size_t gstr = Lidx ? GSTR_S : GSTR_P;
  bf16_t* GA = (bf16_t*)(p.R + (Lidx ? GAS_OFF : GAP_OFF)) + (size_t)(o * 512 + c0) * gstr;
  bf16_t* GB = (bf16_t*)(p.R + (Lidx ? GBS_OFF : GBP_OFF)) + (size_t)(o * 512 + c0) * gstr;
  const float min_decay = -3.0701134573253945f, max_decay = -15.350567286626973f;
  const float tl = (float)t / (float)(L - 1);
#pragma unroll
  for (int cc = 0; cc < 16; ++cc) {
    const float delta = fabsf(min_decay + (float)(c0 + cc) * ((max_decay - min_decay) / 511.f));
    const float win = expf(-tl * delta) + 0.05f;
    const float f = acc[cc] * win, bk = acc[16 + cc] * win;
    bf16_t* ga = GA + (size_t)cc * gstr;
    bf16_t* gb = GB + (size_t)cc * gstr;
    if (t == 0) {
      const bf16_t v = f2bf(f + bk);
      ga[L] = v; gb[L - 1] = v;
      ga[0] = 0;
    } else {
      const bf16_t vf = f2bf(f), vb = f2bf(bk);
      ga[L - t] = vf; gb[L - t - 1] = vf;
      ga[L + t] = vb; gb[L + t - 1] = vb;
    }
  }
}

template <int HALF>
DI void rope4(float (&v)[4], int lr, int pos0) {
  const int idx = lr & (HALF - 1);
  const float inv = exp2f(-((float)idx / (float)HALF) * 18.931568569324174f);
#pragma unroll
  for (int k = 0; k < 4; ++k) {
    const float pv = __shfl_xor(v[k], HALF);
    const float ang = (float)(pos0 + k) * inv;
    const float n = __builtin_rintf(ang * 0.15915494309189535f);
    float r = __builtin_fmaf(-n, 6.28318548202514648f, ang);
    r = __builtin_fmaf(-n, -1.7484555e-7f, r);
    const float fr = r * 0.15915494309189535f;
    const float s = __builtin_amdgcn_sinf(fr), c = __builtin_amdgcn_cosf(fr);
    if (lr < HALF) v[k] = v[k] * c - pv * s;
    else if (lr < 2 * HALF) v[k] = v[k] * c + pv * s;
  }
}

template <int AMODE, int EPI>
DI void gemm_tile(const Params& p, int mt, int nt, int tok0, const float* xcp, const float* xcs,
                          const bf16_t* Ab, const bf16_t* Wt, char* smem) {
  bf16_t* sAB = (bf16_t*)smem;
  float* sR = (float*)(smem + 2 * 2 * 128 * 72 * 2);
  const int tid = otid(), lane = tid & 63, wave = tid >> 6;
  const int wm = wave >> 1, wn = wave & 1;
  const int lr = lane & 31, lh = lane >> 5;
  const int ar = tid >> 4, ac = (tid & 15) * 4;
  const int br = tid >> 3, bc = (tid & 7) * 8;
  const float* arow_f = nullptr; const bf16_t* arow_b = nullptr;
  if (AMODE == 0) {
    const int tokA = tok0 + mt * 128 + ar;
    arow_f = (tokA < 16384 ? xcp + (size_t)tokA * 1024 : xcs + (size_t)(tokA - 16384) * 1024) + ac;
  } else if (AMODE == 1) {
    arow_b = (EPI == 1 ? (const bf16_t*)(p.R + XB_OFF) + (size_t)tok0 * 1024 : (EPI == 0 ? (const bf16_t*)(p.R + XBE_OFF) + (size_t)tok0 * 1024 : Ab)) + (size_t)(mt * 128 + br) * 1024 + bc;
  } else {
    arow_b = (const bf16_t*)(p.R + MIX_OFF) + (size_t)(tid & 63) * NT + tok0 + mt * 128 + 8 * (tid >> 6);
  }
  const bf16_t* ato_b = (const bf16_t*)(p.R + ATO_OFF) + (size_t)(tok0 + mt * 128 + br) * 512 + bc;
  const bf16_t* brow = Wt + (size_t)(nt * 128 + br) * 1024 + bc;
  f32x16 acc[2][2];
#pragma unroll
  for (int a = 0; a < 2; ++a)
#pragma unroll
    for (int b = 0; b < 2; ++b)
#pragma unroll
      for (int i = 0; i < 16; ++i) acc[a][b][i] = 0.f;
  struct Regs { float4 af[AMODE == 0 ? 8 : 1]; u32x4 ab[AMODE == 0 ? 1 : 4]; u32x4 bb[4]; };
  Regs R0, R1;
  float ssq[8];
#pragma unroll
  for (int i = 0; i < 8; ++i) ssq[i] = 0.f;
  auto gload = [&](Regs& R, int kt_) {
    const int kt = kt_ < 16 ? kt_ : 15;
    const int ko = kt * 64;
    if (AMODE == 0) {
#pragma unroll
      for (int i = 0; i < 8; ++i) R.af[i] = *(const float4*)(arow_f + (size_t)i * 16 * 1024 + ko);
    } else if (AMODE == 1) {
#pragma unroll
      for (int i = 0; i < 4; ++i) R.ab[i] = *(const u32x4*)(arow_b + (size_t)i * 32 * 1024 + ko);
    } else {
      if (kt < 8) {
#pragma unroll
        for (int i = 0; i < 4; ++i) R.ab[i] = *(const u32x4*)(arow_b + (size_t)ko * NT + 32 * i);
      } else {
#pragma unroll
        for (int i = 0; i < 4; ++i) R.ab[i] = *(const u32x4*)(ato_b + (size_t)i * 32 * 512 + (ko - 512));
      }
    }
#pragma unroll
    for (int i = 0; i < 4; ++i) R.bb[i] = *(const u32x4*)(brow + (size_t)i * 32 * 1024 + ko);
  };
  auto lstore = [&](const Regs& R, int st, int kt) {
    bf16_t* sA = sAB + st * (2 * 128 * 72);
    bf16_t* sB = sA + 128 * 72;
    if (AMODE == 0) {
#pragma unroll
      for (int i = 0; i < 8; ++i) {
        ssq[i] += R.af[i].x * R.af[i].x + R.af[i].y * R.af[i].y + R.af[i].z * R.af[i].z + R.af[i].w * R.af[i].w;
        u32x2 w; w[0] = pack2(R.af[i].x, R.af[i].y); w[1] = pack2(R.af[i].z, R.af[i].w);
        *(u32x2*)(sA + (ar + 16 * i) * 72 + ac) = w;
      }
    } else if (AMODE == 2 && kt < 8) {
      const int kk = tid & 63, tq = tid >> 6;
#pragma unroll
      for (int i = 0; i < 4; ++i)
#pragma unroll
        for (int q = 0; q < 4; ++q) {
          sA[(8 * (tq + 4 * i) + 2 * q) * 72 + kk] = (bf16_t)(R.ab[i][q] & 0xffffu);
          sA[(8 * (tq + 4 * i) + 2 * q + 1) * 72 + kk] = (bf16_t)(R.ab[i][q] >> 16);
        }
    } else {
#pragma unroll
      for (int i = 0; i < 4; ++i) {
        if (AMODE == 1 && EPI != 2) { ssq[i] = dot2sq(R.ab[i][0], ssq[i]); ssq[i] = dot2sq(R.ab[i][1], ssq[i]); ssq[i] = dot2sq(R.ab[i][2], ssq[i]); ssq[i] = dot2sq(R.ab[i][3], ssq[i]); }
        *(u32x4*)(sA + (br + 32 * i) * 72 + bc) = R.ab[i];
      }
    }
#pragma unroll
    for (int i = 0; i < 4; ++i) *(u32x4*)(sB + (br + 32 * i) * 72 + bc) = R.bb[i];
  };
  auto compute = [&](int st) {
    const bf16_t* sA = sAB + st * (2 * 128 * 72);
    const bf16_t* sB = sA + 128 * 72;
#pragma unroll
    for (int ks = 0; ks < 4; ++ks) {
      bf16x8 a[2], b[2];
#pragma unroll
      for (int mi = 0; mi < 2; ++mi) a[mi] = *(const bf16x8*)(sA + (wm * 64 + mi * 32 + lr) * 72 + ks * 16 + lh * 8);
#pragma unroll
      for (int ni = 0; ni < 2; ++ni) b[ni] = *(const bf16x8*)(sB + (wn * 64 + ni * 32 + lr) * 72 + ks * 16 + lh * 8);
#pragma unroll
      for (int mi = 0; mi < 2; ++mi)
#pragma unroll
        for (int ni = 0; ni < 2; ++ni) acc[mi][ni] = MFMA32(a[mi], b[ni], acc[mi][ni]);
    }
  };
  __syncthreads();
  if (AMODE == 0) {
    gload(R0, 0);
    lstore(R0, 0, 0);
    gload(R0, 1);
    __syncthreads();
#pragma unroll 1
    for (int kt = 0; kt < 16; ++kt) {
      compute(kt & 1);
      if (kt + 1 < 16) lstore(R0, (kt + 1) & 1, kt + 1);
      gload(R0, kt + 2);
      __syncthreads();
    }
  } else {
    gload(R0, 0);
    gload(R1, 1);
    lstore(R0, 0, 0);
    gload(R0, 2);
    __syncthreads();
#pragma unroll 1
    for (int kt = 0; kt < 16; kt += 2) {
      compute(0);
      lstore(R1, 1, kt + 1);
      gload(R1, kt + 3);
      __syncthreads();
      compute(1);
      if (kt + 2 < 16) lstore(R0, 0, kt + 2);
      gload(R0, kt + 4);
      __syncthreads();
    }
  }
  if (AMODE == 0) {
#pragma unroll
    for (int i = 0; i < 8; ++i) {
      float v = ssq[i];
      v += __shfl_xor(v, 1); v += __shfl_xor(v, 2); v += __shfl_xor(v, 4); v += __shfl_xor(v, 8);
      if ((tid & 15) == 0) sR[ar + 16 * i] = rsqrtf(v * (1.f / 1024.f) + 1e-6f);
    }
    __syncthreads();
  } else if (AMODE == 1 && EPI != 2) {
#pragma unroll
    for (int i = 0; i < 4; ++i) {
      float v = ssq[i];
      v += __shfl_xor(v, 1); v += __shfl_xor(v, 2); v += __shfl_xor(v, 4);
      if ((tid & 7) == 0) sR[br + 32 * i] = rsqrtf(v * (1.f / 1024.f) + 1e-6f);
    }
    __syncthreads();
  }
  const int rowbase = mt * 128;
  if (EPI == 2) {
#pragma unroll
    for (int mi = 0; mi < 2; ++mi)
#pragma unroll
      for (int ni = 0; ni < 2; ++ni) {
        const int col = nt * 128 + wn * 64 + ni * 32 + lr;
#pragma unroll
        for (int gi = 0; gi < 4; ++gi) {
          const int row4 = wm * 64 + mi * 32 + 8 * gi + 4 * lh;
          const int tok = tok0 + rowbase + row4;
#pragma unroll
          for (int k = 0; k < 4; ++k) {
            const int tk = tok + k;
            const float* xr = (tk < 16384 ? xcp + (size_t)tk * 1024 : xcs + (size_t)(tk - 16384) * 1024);
            const float xn = xr[col] + acc[mi][ni][4 * gi + k];
            p.out[(size_t)tk * 1024 + col] = xn;
            ((bf16_t*)(p.R + (AMODE == 2 ? XB_OFF : XBE_OFF)))[(size_t)tk * 1024 + col] = f2bf(xn);
          }
        }
      }
    return;
  }
  bool colmajor; int ropehalf = 0; float scl = 1.f; int kind = 0; bf16_t* fbase = nullptr;
  bf16_t* dst; size_t dld;
  int sh = 0;
  if (EPI == 0) {
    const int tb = tok0 + rowbase;
    if (nt < 12) { colmajor = true; dst = (bf16_t*)(p.R + U_OFF) + (size_t)(nt * 128) * NT + tb; dld = NT; }
    else if (nt < 16) { colmajor = true; dst = (bf16_t*)(p.R + HG_OFF) + (size_t)((nt - 12) * 128) * NT + tb; dld = NT; }
    else if (nt < 20) { colmajor = false; ropehalf = 8; scl = 0.125f * LOG2E; dst = (bf16_t*)(p.R + Q_OFF) + (size_t)tb * 512 + (nt - 16) * 128; dld = 512; }
    else if (nt == 20) { colmajor = false; ropehalf = 8; kind = 1; fbase = (bf16_t*)(p.R + K_OFF); dst = nullptr; dld = 0; }
    else if (nt == 21) { colmajor = true; kind = 2; fbase = (bf16_t*)(p.R + VT_OFF); dst = nullptr; dld = 0; }
    else { colmajor = false; dst = (bf16_t*)(p.R + AG_OFF) + (size_t)tb * 512 + (nt - 22) * 128; dld = 512; }
  } else {
    if (nt >= 72) { colmajor = false; dst = (bf16_t*)(p.R + GO_OFF) + ((size_t)((tok0 >> 14) & 1) * CH + rowbase) * 1024 + (nt - 72) * 128; dld = 1024; }
    else {
      const int g = nt / 24, which = (nt % 24) / 8, head = nt & 7;
      if (which < 2) {
        colmajor = false; ropehalf = 16; scl = which == 0 ? (0.08838834764831845f * LOG2E) : 1.f;
        dst = (bf16_t*)(p.R + QO_OFF) + ((size_t)g * CH + rowbase) * 1024 + head * 128; dld = 1024;
        sh = g == 0 ? 0 : (g == 1 ? 2 : 4);
        if (which == 1) { kind = 1; fbase = (bf16_t*)(p.R + KO_OFF) + ((size_t)g * 8 + head) * CH * 128; }
      } else {
        colmajor = true; sh = g == 0 ? 0 : (g == 1 ? 2 : 4);
        kind = 2; fbase = (bf16_t*)(p.R + VTO_OFF) + ((size_t)g * 8 + head) * CH * 128; dst = nullptr; dld = 0;
      }
    }
  }
  bf16_t* sC = (bf16_t*)smem;
  const int pos_base = tok0 + rowbase - seq_start_of(tok0 + rowbase);
#pragma unroll
  for (int mi = 0; mi < 2; ++mi)
#pragma unroll
    for (int ni = 0; ni < 2; ++ni) {
      const int cl = wn * 64 + ni * 32 + lr;
#pragma unroll
      for (int gi = 0; gi < 4; ++gi) {
        const int row4 = wm * 64 + mi * 32 + 8 * gi + 4 * lh;
        float v[4];
#pragma unroll
        for (int k = 0; k < 4; ++k) v[k] = acc[mi][ni][4 * gi + k] * sR[row4 + k];
        if (ropehalf == 8) { if (ni == 0) rope4<8>(v, lr, pos_base + row4); }
        else if (ropehalf == 16) { if (wn == 0 && ni == 0) rope4<16>(v, lr, pos_base + row4); }
        if (colmajor) {
          u32x2 w; w[0] = pack2(v[0], v[1]); w[1] = pack2(v[2], v[3]);
          *(u32x2*)(sC + cl * 136 + row4) = w;
        } else {
          const unsigned w0 = pack2(v[0] * scl, v[1] * scl), w1 = pack2(v[2] * scl, v[3] * scl);
          sC[(row4 + 0) * 136 + cl] = (bf16_t)(w0 & 0xffffu); sC[(row4 + 1) * 136 + cl] = (bf16_t)(w0 >> 16);
          sC[(row4 + 2) * 136 + cl] = (bf16_t)(w1 & 0xffffu); sC[(row4 + 3) * 136 + cl] = (bf16_t)(w1 >> 16);
        }
      }
    }
  __syncthreads();
  const int Lq = (EPI == 0) ? 0 : (tok0 == 0 ? 16384 : 4096);
  const int Ls = Lq >> sh;
  const int seqoff = (EPI == 0) ? 0 : (rowbase & ~(Lq - 1));
  const int dmask = (1 << sh) - 1;
  if (kind == 0) {
#pragma unroll
    for (int i = 0; i < 8; ++i) {
      const int chunk = tid + 256 * i;
      const int a_ = chunk >> 4, c8 = (chunk & 15) * 8;
      const u32x4 w = *(const u32x4*)(sC + a_ * 136 + c8);
      *(u32x4*)(dst + (size_t)a_ * dld + c8) = w;
    }
  } else if (kind == 1) {
#pragma unroll
    for (int i = 0; i < 8; ++i) {
      const int chunk = tid + 256 * i;
      const int a_ = chunk >> 4, c8 = (chunk & 15) * 8;
      const u32x4 w = *(const u32x4*)(sC + a_ * 136 + c8);
      int vt, hsel, d8, KS;
      if (EPI == 0) { vt = tok0 + rowbase + a_; hsel = c8 >> 6; d8 = c8 & 63; KS = 4; }
      else { const int n = rowbase + a_ - seqoff; vt = seqoff + (n & dmask) * Ls + (n >> sh); hsel = 0; d8 = c8; KS = 8; }
      const int kk = vt & 31;
      const int rho = ((kk >> 3) & 1) * 16 + ((kk >> 2) & 1) * 8 + (kk >> 4) * 4 + (kk & 3);
      bf16_t* dk = fbase + (size_t)hsel * NT * 64 + ((size_t)((vt >> 5) * KS + (d8 >> 4)) * 64 + ((d8 >> 3) & 1) * 32 + rho) * 8;
      *(u32x4*)dk = w;
    }
  } else {
    const int nb_s = (rowbase - seqoff) >> sh;
    const int d = 1 << sh;
#pragma unroll
    for (int i = 0; i < 8; ++i) {
      const int chunk = tid + 256 * i;
      const int a_ = chunk >> 4, c16 = chunk & 15;
      u32x4 w; int v8;
      if (sh == 0) {
        w = *(const u32x4*)(sC + a_ * 136 + c16 * 8);
        v8 = (EPI == 0 ? tok0 : 0) + rowbase + c16 * 8;
      } else {
        const int r = sh == 2 ? (c16 >> 2) : c16;
        const int sg = sh == 2 ? (c16 & 3) : 0;
        const bf16_t* sp = sC + a_ * 136 + sg * 8 * d + r;
#pragma unroll
        for (int q = 0; q < 4; ++q) w[q] = (unsigned)sp[(2 * q) * d] | ((unsigned)sp[(2 * q + 1) * d] << 16);
        v8 = seqoff + r * Ls + nb_s + sg * 8;
      }
      const int hsel = EPI == 0 ? (a_ >> 6) : 0;
      const int dim = EPI == 0 ? (a_ & 63) : a_;
      const int DT = EPI == 0 ? 2 : 4;
      const int within = v8 & 31;
      bf16_t* dv = fbase + (size_t)hsel * NT * 64 + ((((size_t)(v8 >> 5) * DT + (dim >> 5)) * 2 + ((within >> 3) & 1)) * 64 + (within >> 4) * 32 + (dim & 31)) * 8;
      *(u32x4*)dv = w;
    }
  }
}

template <int AMODE, int EPI>
DI void gemm_run(const Params& p, int jfirst, int njobs, int jstride, int ntn, int tok0, const float* xcp, const float* xcs,
                 const bf16_t* Ab, const bf16_t* Wt, char* smem) {
  if (jfirst >= njobs) return;
  bf16_t* sAB = (bf16_t*)smem;
  float* sR = (float*)(smem + 2 * 2 * 128 * 72 * 2);
  const int tid = otid(), lane = tid & 63, wave = __builtin_amdgcn_readfirstlane(tid >> 6);
  const int wm = wave >> 1, wn = wave & 1;
  const int lr = lane & 31, lh = lane >> 5;
  const int ar = tid >> 4, ac = (tid & 15) * 4;
  const int br = tid >> 3, bc = (tid & 7) * 8;
  struct Ptrs { const char* a; const char* a2; const char* b; };
  const unsigned voffF = (unsigned)(ar * 1024 + ac) * 4u;
  const unsigned voffB = (unsigned)(br * 1024 + bc) * 2u;
  const unsigned voffH = ((unsigned)(tid >> 4) * (unsigned)NT + 8u * (unsigned)(tid & 15)) * 2u;
  const unsigned voffT = (unsigned)(br * 512 + bc) * 2u;
  auto setup = [&](int j, Ptrs& P) {
    const int mt = j / ntn, nt = j - mt * ntn;
    const int tokA = tok0 + mt * 128;
    P.a2 = nullptr;
    if (AMODE == 0) {
      P.a = (const char*)(tokA < 16384 ? xcp + (size_t)tokA * 1024 : xcs + (size_t)(tokA - 16384) * 1024);
    } else if (AMODE == 1) {
      P.a = (const char*)((EPI == 1 ? (const bf16_t*)(p.R + XB_OFF) + (size_t)tok0 * 1024 : (EPI == 0 ? (const bf16_t*)(p.R + XBE_OFF) + (size_t)tok0 * 1024 : Ab)) + (size_t)(mt * 128) * 1024);
    } else {
      P.a = (const char*)((const bf16_t*)(p.R + MIX_OFF) + tokA);
      P.a2 = (const char*)((const bf16_t*)(p.R + ATO_OFF) + (size_t)tokA * 512);
    }
    P.b = (const char*)(Wt + (size_t)(nt * 128) * 1024);
  };
  struct Regs { float4 af[AMODE == 0 ? 8 : 1]; u32x4 ab[AMODE == 0 ? 1 : 4]; u32x4 bb[4]; };
  Regs R0, R1;
  float ssq[8];
#pragma unroll
  for (int i = 0; i < 8; ++i) ssq[i] = 0.f;
  Ptrs Pc, Pn;
  bool hasn = false;
  auto gload = [&](Regs& R, int kv) {
    const bool nx = kv >= 16 && hasn;
    const int kt = kv >= 16 ? (hasn ? kv - 16 : 15) : kv;
    const char* pa = nx ? Pn.a : Pc.a;
    const char* pa2 = nx ? Pn.a2 : Pc.a2;
    const char* pb = nx ? Pn.b : Pc.b;
    const int ko = kt * 64;
    if (AMODE == 0) {
      const char* q = pa + (size_t)ko * 4;
#pragma unroll
      for (int i = 0; i < 8; ++i) R.af[i] = *(const float4*)(q + (size_t)i * 16 * 4096 + voffF);
    } else if (AMODE == 1) {
      const char* q = pa + (size_t)ko * 2;
#pragma unroll
      for (int i = 0; i < 4; ++i) R.ab[i] = *(const u32x4*)(q + (size_t)i * 32 * 2048 + voffB);
    } else {
      if (kt < 8) {
        const char* q = pa + (size_t)ko * NT * 2;
#pragma unroll
        for (int i = 0; i < 4; ++i) R.ab[i] = *(const u32x4*)(q + (size_t)i * 16 * NT * 2 + voffH);
      } else {
        const char* q = pa2 + (size_t)(ko - 512) * 2;
#pragma unroll
        for (int i = 0; i < 4; ++i) R.ab[i] = *(const u32x4*)(q + (size_t)i * 32 * 1024 + voffT);
      }
    }
    const char* qb = pb + (size_t)ko * 2;
#pragma unroll
    for (int i = 0; i < 4; ++i) R.bb[i] = *(const u32x4*)(qb + (size_t)i * 32 * 2048 + voffB);
  };
  auto lstore = [&](const Regs& R, int st, int kv) {
    const int kt = kv & 15;
    bf16_t* sA = sAB + st * (2 * 128 * 72);
    bf16_t* sB = sA + 128 * 72;
    if (AMODE == 0) {
#pragma unroll
      for (int i = 0; i < 8; ++i) {
        ssq[i] += R.af[i].x * R.af[i].x + R.af[i].y * R.af[i].y + R.af[i].z * R.af[i].z + R.af[i].w * R.af[i].w;
        u32x2 w; w[0] = pack2(R.af[i].x, R.af[i].y); w[1] = pack2(R.af[i].z, R.af[i].w);
        *(u32x2*)(sA + (ar + 16 * i) * 72 + ac) = w;
      }
    } else if (AMODE == 2 && kt < 8) {
#pragma unroll
      for (int i = 0; i < 4; ++i) *(u32x4*)((char*)sA + ((tid >> 4) + 16 * i) * 272 + (tid & 15) * 16) = R.ab[i];
    } else {
#pragma unroll
      for (int i = 0; i < 4; ++i) {
        if (AMODE == 1 && EPI != 2) { ssq[i] = dot2sq(R.ab[i][0], ssq[i]); ssq[i] = dot2sq(R.ab[i][1], ssq[i]); ssq[i] = dot2sq(R.ab[i][2], ssq[i]); ssq[i] = dot2sq(R.ab[i][3], ssq[i]); }
        *(u32x4*)(sA + (br + 32 * i) * 72 + bc) = R.ab[i];
      }
    }
#pragma unroll
    for (int i = 0; i < 4; ++i) *(u32x4*)(sB + (br + 32 * i) * 72 + bc) = R.bb[i];
  };
  const int l15 = lane & 15, kg = lane >> 4;
  f32x4 acc[4][4];
  typedef __attribute__((ext_vector_type(4))) short s16x4_t;
  auto compute = [&](int st, int ktile) {
    const bf16_t* sA = sAB + st * (2 * 128 * 72);
    const bf16_t* sB = sA + 128 * 72;
    const bool trA = (AMODE == 2) && (ktile < 8);
#pragma unroll
    for (int ks = 0; ks < 2; ++ks) {
      bf16x8 a[4], b[4];
      if (trA) {
        const char* tb = (const char*)sA + 272 * (32 * ks + 8 * kg + ((lane & 15) >> 2)) + 8 * (lane & 3);
#pragma unroll
        for (int mi = 0; mi < 4; ++mi) {
          const int c = 4 * wm + mi;
          const s16x4_t lo = __builtin_amdgcn_ds_read_tr16_b64_v4i16((__attribute__((address_space(3))) s16x4_t*)(tb + 32 * c));
          const s16x4_t hi = __builtin_amdgcn_ds_read_tr16_b64_v4i16((__attribute__((address_space(3))) s16x4_t*)(tb + 32 * c + 272 * 4));
          a[mi] = __builtin_shufflevector(lo, hi, 0, 1, 2, 3, 4, 5, 6, 7);
        }
      } else {
#pragma unroll
        for (int mi = 0; mi < 4; ++mi) a[mi] = *(const bf16x8*)(sA + (wm * 64 + mi * 16 + l15) * 72 + ks * 32 + kg * 8);
      }
#pragma unroll
      for (int ni = 0; ni < 4; ++ni) b[ni] = *(const bf16x8*)(sB + (wn * 64 + ni * 16 + l15) * 72 + ks * 32 + kg * 8);
#pragma unroll
      for (int mi = 0; mi < 4; ++mi)
#pragma unroll
        for (int ni = 0; ni < 4; ++ni) acc[mi][ni] = __builtin_amdgcn_mfma_f32_16x16x32_bf16(a[mi], b[ni], acc[mi][ni], 0, 0, 0);
    }
  };
  auto finish_rstd = [&]() {
    if (AMODE == 0) {
#pragma unroll
      for (int i = 0; i < 8; ++i) {
        float v = ssq[i];
        v += __shfl_xor(v, 1); v += __shfl_xor(v, 2); v += __shfl_xor(v, 4); v += __shfl_xor(v, 8);
        if ((tid & 15) == 0) sR[ar + 16 * i] = rsqrtf(v * (1.f / 1024.f) + 1e-6f);
        ssq[i] = 0.f;
      }
    } else if (AMODE == 1 && EPI != 2) {
#pragma unroll
      for (int i = 0; i < 4; ++i) {
        float v = ssq[i];
        v += __shfl_xor(v, 1); v += __shfl_xor(v, 2); v += __shfl_xor(v, 4);
        if ((tid & 7) == 0) sR[br + 32 * i] = rsqrtf(v * (1.f / 1024.f) + 1e-6f);
        ssq[i] = 0.f;
      }
    }
  };
  int jcur = jfirst;
  setup(jcur, Pc);
  __syncthreads();
  gload(R0, 0);
  if (AMODE != 0) gload(R1, 1);
  lstore(R0, 0, 0);
  gload(R0, AMODE == 0 ? 1 : 2);
  __syncthreads();
#pragma unroll 1
  for (;;) {
    const int jn = jcur + jstride;
    hasn = jn < njobs;
    if (hasn) setup(jn, Pn);
    const int mt = jcur / ntn, nt = jcur - mt * ntn;
    float zf = 0.f;
    asm volatile("" : "+v"(zf));
#pragma unroll
    for (int a_ = 0; a_ < 4; ++a_)
#pragma unroll
      for (int b_ = 0; b_ < 4; ++b_)
#pragma unroll
        for (int i = 0; i < 4; ++i) acc[a_][b_][i] = zf;
    __builtin_amdgcn_s_setprio(2);
    if (AMODE == 0) {
#pragma unroll 1
      for (int kt = 0; kt < 16; ++kt) {
        compute(kt & 1, kt);
        if (kt == 15) finish_rstd();
        lstore(R0, (kt + 1) & 1, kt + 1);
        gload(R0, kt + 2);
        __syncthreads();
      }
    } else {
#pragma unroll 1
      for (int kt = 0; kt < 16; kt += 2) {
        compute(0, kt);
        lstore(R1, 1, kt + 1);
        gload(R1, kt + 3);
        __syncthreads();
        compute(1, kt + 1);
        if (kt == 14) finish_rstd();
        lstore(R0, 0, kt + 2);
        gload(R0, kt + 4);
        __syncthreads();
      }
    }
    __builtin_amdgcn_s_setprio(0);
  const int rowbase = mt * 128;
  if (EPI == 2) {
    const float* xbase = (tok0 + rowbase) < 16384 ? xcp : xcs - (size_t)16384 * 1024;
#pragma unroll
    for (int mi = 0; mi < 4; ++mi) {
#pragma unroll
      for (int ni = 0; ni < 4; ++ni) {
        const int col = nt * 128 + wn * 64 + ni * 16 + l15;
        const int tok = tok0 + rowbase + wm * 64 + mi * 16 + 4 * kg;
#pragma unroll
        for (int k = 0; k < 4; ++k) {
          const unsigned off = (unsigned)(tok + k) * 1024u + (unsigned)col;
          const float xn = xbase[off] + acc[mi][ni][k];
          p.out[off] = xn;
          ((bf16_t*)(p.R + (AMODE == 2 ? XB_OFF : XBE_OFF)))[off] = f2bf(xn);
        }
      }
      __builtin_amdgcn_sched_barrier(0);
    }
  } else {
  bool colmajor; int ropehalf = 0; float scl = 1.f; int kind = 0; bf16_t* fbase = nullptr;
  bf16_t* dst; size_t dld;
  int sh = 0;
  if (EPI == 0) {
    const int tb = tok0 + rowbase;
    if (nt < 12) { colmajor = true; dst = (bf16_t*)(p.R + U_OFF) + (size_t)(nt * 128) * NT + tb; dld = NT; }
    else if (nt < 16) { colmajor = true; dst = (bf16_t*)(p.R + HG_OFF) + (size_t)((nt - 12) * 128) * NT + tb; dld = NT; }
    else if (nt < 20) { colmajor = false; ropehalf = 8; scl = 0.125f * LOG2E; dst = (bf16_t*)(p.R + Q_OFF) + (size_t)tb * 512 + (nt - 16) * 128; dld = 512; }
    else if (nt == 20) { colmajor = false; ropehalf = 8; kind = 1; fbase = (bf16_t*)(p.R + K_OFF); dst = nullptr; dld = 0; }
    else if (nt == 21) { colmajor = true; kind = 2; fbase = (bf16_t*)(p.R + VT_OFF); dst = nullptr; dld = 0; }
    else { colmajor = false; dst = (bf16_t*)(p.R + AG_OFF) + (size_t)tb * 512 + (nt - 22) * 128; dld = 512; }
  } else {
    if (nt >= 72) { colmajor = false; dst = (bf16_t*)(p.R + GO_OFF) + ((size_t)((tok0 >> 14) & 1) * CH + rowbase) * 1024 + (nt - 72) * 128; dld = 1024; }
    else {
      const int g = nt / 24, which = (nt % 24) / 8, head = nt & 7;
      if (which < 2) {
        colmajor = false; ropehalf = 16; scl = which == 0 ? (0.08838834764831845f * LOG2E) : 1.f;
        dst = (bf16_t*)(p.R + QO_OFF) + ((size_t)g * CH + rowbase) * 1024 + head * 128; dld = 1024;
        sh = g == 0 ? 0 : (g == 1 ? 2 : 4);
        if (which == 1) { kind = 1; fbase = (bf16_t*)(p.R + KO_OFF) + ((size_t)g * 8 + head) * CH * 128; }
      } else {
        colmajor = true; sh = g == 0 ? 0 : (g == 1 ? 2 : 4);
        kind = 2; fbase = (bf16_t*)(p.R + VTO_OFF) + ((size_t)g * 8 + head) * CH * 128; dst = nullptr; dld = 0;
      }
    }
  }
  bf16_t* sC = (bf16_t*)(smem + 2 * 128 * 72 * 2);
  const int pos_base = tok0 + rowbase - seq_start_of(tok0 + rowbase);
#pragma unroll
  for (int mi = 0; mi < 4; ++mi) {
    const int row4 = wm * 64 + mi * 16 + 4 * kg;
    float rs[4];
#pragma unroll
    for (int k = 0; k < 4; ++k) rs[k] = sR[row4 + k];
    float v[4][4];
#pragma unroll
    for (int ni = 0; ni < 4; ++ni)
#pragma unroll
      for (int k = 0; k < 4; ++k) v[ni][k] = acc[mi][ni][k] * rs[k];
    if (ropehalf == 8) {
      rope4<8>(v[0], l15, pos_base + row4);
    } else if (ropehalf == 16) {
      if (wn == 0) {
        const float inv = exp2f(-((float)l15 / 16.f) * 18.931568569324174f);
#pragma unroll
        for (int k = 0; k < 4; ++k) {
          const float ang = (float)(pos_base + row4 + k) * inv;
          const float n = __builtin_rintf(ang * 0.15915494309189535f);
          float r = __builtin_fmaf(-n, 6.28318548202514648f, ang);
          r = __builtin_fmaf(-n, -1.7484555e-7f, r);
          const float fr = r * 0.15915494309189535f;
          const float sn = __builtin_amdgcn_sinf(fr), cs = __builtin_amdgcn_cosf(fr);
          const float x1 = v[0][k], x2 = v[1][k];
          v[0][k] = x1 * cs - x2 * sn;
          v[1][k] = x2 * cs + x1 * sn;
        }
      }
    }
#pragma unroll
    for (int ni = 0; ni < 4; ++ni) {
      const int cl = wn * 64 + ni * 16 + l15;
      if (colmajor) {
        u32x2 w; w[0] = pack2(v[ni][0], v[ni][1]); w[1] = pack2(v[ni][2], v[ni][3]);
        *(u32x2*)(sC + cl * 136 + row4) = w;
      } else {
        const unsigned w0 = pack2(v[ni][0] * scl, v[ni][1] * scl), w1 = pack2(v[ni][2] * scl, v[ni][3] * scl);
        sC[(row4 + 0) * 136 + cl] = (bf16_t)(w0 & 0xffffu); sC[(row4 + 1) * 136 + cl] = (bf16_t)(w0 >> 16);
        sC[(row4 + 2) * 136 + cl] = (bf16_t)(w1 & 0xffffu); sC[(row4 + 3) * 136 + cl] = (bf16_t)(w1 >> 16);
      }
    }
    asm volatile("" ::: "memory");
  }
  __syncthreads();
  const int Lq = (EPI == 0) ? 0 : (tok0 == 0 ? 16384 : 4096);
  const int Ls = Lq >> sh;
  const int seqoff = (EPI == 0) ? 0 : (rowbase & ~(Lq - 1));
  const int dmask = (1 << sh) - 1;
  if (kind == 0) {
#pragma unroll 4
    for (int i = 0; i < 8; ++i) {
      const int chunk = tid + 256 * i;
      const int a_ = chunk >> 4, c8 = (chunk & 15) * 8;
      const u32x4 w = *(const u32x4*)(sC + a_ * 136 + c8);
      *(u32x4*)(dst + (size_t)a_ * dld + c8) = w;
    }
  } else if (kind == 1 && sh != 4) {
    const int KS = EPI == 0 ? 4 : 8;
#pragma unroll 4
    for (int i = 0; i < 8; ++i) {
      const int chunk = tid + 256 * i;
      const int rho = chunk & 31, lhd = (chunk >> 5) & 1, ksx = (chunk >> 6) & 7, blk = chunk >> 9;
      const int kap = ((rho >> 2) & 1) * 16 + (rho >> 4) * 8 + ((rho >> 3) & 1) * 4 + (rho & 3);
      const int a_ = sh == 0 ? 32 * blk + kap : 4 * kap + blk;
      const u32x4 w = *(const u32x4*)(sC + a_ * 136 + (ksx * 2 + lhd) * 8);
      const int hsel = EPI == 0 ? (ksx >> 2) : 0;
      const int ks = EPI == 0 ? (ksx & 3) : ksx;
      const int blockid = sh == 0 ? (((EPI == 0 ? tok0 : 0) + rowbase) >> 5) + blk
                                  : (seqoff + blk * Ls + ((rowbase - seqoff) >> sh)) >> 5;
      bf16_t* dk = fbase + (size_t)hsel * NT * 64 + ((size_t)(blockid * KS + ks) * 64 + lhd * 32 + rho) * 8;
      *(u32x4*)dk = w;
    }
  } else if (kind == 1) {
#pragma unroll 4
    for (int i = 0; i < 8; ++i) {
      const int chunk = tid + 256 * i;
      const int a_ = chunk >> 4, c8 = (chunk & 15) * 8;
      const u32x4 w = *(const u32x4*)(sC + a_ * 136 + c8);
      int vt, hsel, d8, KS;
      if (EPI == 0) { vt = tok0 + rowbase + a_; hsel = c8 >> 6; d8 = c8 & 63; KS = 4; }
      else { const int n = rowbase + a_ - seqoff; vt = seqoff + (n & dmask) * Ls + (n >> sh); hsel = 0; d8 = c8; KS = 8; }
      const int kk = vt & 31;
      const int rho = ((kk >> 3) & 1) * 16 + ((kk >> 2) & 1) * 8 + (kk >> 4) * 4 + (kk & 3);
      bf16_t* dk = fbase + (size_t)hsel * NT * 64 + ((size_t)((vt >> 5) * KS + (d8 >> 4)) * 64 + ((d8 >> 3) & 1) * 32 + rho) * 8;
      *(u32x4*)dk = w;
    }
  } else if (sh != 4) {
    const int DT = EPI == 0 ? 2 : 4;
#pragma unroll 4
    for (int i = 0; i < 8; ++i) {
      const int chunk = tid + 256 * i;
      const int d31 = chunk & 31, lhv = (chunk >> 5) & 1, sv = (chunk >> 6) & 1, dtx = (chunk >> 7) & 3, blk = chunk >> 9;
      const int a_ = dtx * 32 + d31;
      const int within = 16 * lhv + 8 * sv;
      u32x4 w; int blockid;
      if (sh == 0) {
        w = *(const u32x4*)(sC + a_ * 136 + 32 * blk + within);
        blockid = (((EPI == 0 ? tok0 : 0) + rowbase) >> 5) + blk;
      } else {
        const bf16_t* sp = sC + a_ * 136 + within * 4 + blk;
#pragma unroll
        for (int q = 0; q < 4; ++q) w[q] = (unsigned)sp[(2 * q) * 4] | ((unsigned)sp[(2 * q + 1) * 4] << 16);
        blockid = (seqoff + blk * Ls + ((rowbase - seqoff) >> sh)) >> 5;
      }
      const int hsel = EPI == 0 ? (dtx >> 1) : 0;
      const int dt = EPI == 0 ? (dtx & 1) : dtx;
      bf16_t* dv = fbase + (size_t)hsel * NT * 64 + ((((size_t)blockid * DT + dt) * 2 + sv) * 64 + lhv * 32 + d31) * 8;
      *(u32x4*)dv = w;
    }
  } else {
    const int nb_s = (rowbase - seqoff) >> sh;
    const int d = 1 << sh;
#pragma unroll 4
    for (int i = 0; i < 8; ++i) {
      const int chunk = tid + 256 * i;
      const int a_ = chunk >> 4, c16 = chunk & 15;
      u32x4 w; int v8;
      if (sh == 0) {
        w = *(const u32x4*)(sC + a_ * 136 + c16 * 8);
        v8 = (EPI == 0 ? tok0 : 0) + rowbase + c16 * 8;
      } else {
        const int r = sh == 2 ? (c16 >> 2) : c16;
        const int sg = sh == 2 ? (c16 & 3) : 0;
        const bf16_t* sp = sC + a_ * 136 + sg * 8 * d + r;
#pragma unroll
        for (int q = 0; q < 4; ++q) w[q] = (unsigned)sp[(2 * q) * d] | ((unsigned)sp[(2 * q + 1) * d] << 16);
        v8 = seqoff + r * Ls + nb_s + sg * 8;
      }
      const int hsel = EPI == 0 ? (a_ >> 6) : 0;
      const int dim = EPI == 0 ? (a_ & 63) : a_;
      const int DT = EPI == 0 ? 2 : 4;
      const int within = v8 & 31;
      bf16_t* dv = fbase + (size_t)hsel * NT * 64 + ((((size_t)(v8 >> 5) * DT + (dim >> 5)) * 2 + ((within >> 3) & 1)) * 64 + (within >> 4) * 32 + (dim & 31)) * 8;
      *(u32x4*)dv = w;
    }
  }
  }
    __syncthreads();
    if (!hasn) break;
    jcur = jn; Pc = Pn;
  }
}

template <int HD, bool EVEN>
DI void attn_wave(const bf16_t* __restrict__ Qb, int qs, const bf16_t* __restrict__ KFb,
                  const bf16_t* __restrict__ VFb, int Ls, int dil, int res, int s0, int R,
                  float m_init, float l_init, bf16_t* __restrict__ Ob, int os,
                  const bf16_t* __restrict__ Gb, int gs, float* __restrict__ lse_b) {
  const int lane = otid() & 63, lr = lane & 31, lh = lane >> 5;
  constexpr bool QREG = true;
  bf16x8 qf[QREG ? HD / 16 : 1];
  const bf16_t* qp = Qb + (size_t)((s0 + lr) * dil + res) * qs + lh * 8;
  if (QREG) {
#pragma unroll
    for (int ks = 0; ks < HD / 16; ++ks) qf[ks] = *(const bf16x8*)(qp + ks * 16);
  }
  f32x16 O[HD / 32];
#pragma unroll
  for (int dt = 0; dt < HD / 32; ++dt)
#pragma unroll
    for (int i = 0; i < 16; ++i) O[dt][i] = 0.f;
  float m = m_init;
  float l = (lh == 0) ? l_init : 0.f;
  const int qq = s0 + lr;
  for (int kb = s0 - R; kb <= s0 + R; kb += 32) {
    if (kb + 31 < 0 || kb >= Ls) continue;
    const bf16_t* kp = KFb + ((size_t)(kb >> 5) * (HD / 16) * 64 + lane) * 8;
    bf16x8 vfr[2][HD / 32];
    {
      const bf16_t* vp = VFb + ((size_t)(kb >> 5) * (HD / 32) * 2 * 64 + lane) * 8;
#pragma unroll
      for (int dt = 0; dt < HD / 32; ++dt)
#pragma unroll
        for (int s2 = 0; s2 < 2; ++s2) vfr[s2][dt] = *(const bf16x8*)(vp + (dt * 2 + s2) * 512);
    }
    f32x16 S;
#pragma unroll
    for (int i = 0; i < 16; ++i) S[i] = 0.f;
#pragma unroll
    for (int ks = 0; ks < HD / 16; ++ks) S = MFMA32(*(const bf16x8*)(kp + ks * 512), qf[ks], S);
    float mx = -1e30f;
    unsigned okm = 0;
    const bool interior = (kb >= s0 + 31 - R) && (kb <= s0 + R - 31);
    if (interior) {
      okm = 0xFFFFu;
#pragma unroll
      for (int i = 0; i < 16; ++i) mx = fmaxf(mx, S[i]);
    } else {
#pragma unroll
      for (int i = 0; i < 16; ++i) {
        const int kk = kb + 16 * lh + i;
        const bool ok = (unsigned)(kk - qq + R) <= (unsigned)(2 * R);
        okm |= ok ? (1u << i) : 0u;
        S[i] = ok ? S[i] : -1e30f;
        mx = fmaxf(mx, S[i]);
      }
    }
    mx = xhalf_max(mx);
    const float mn = fmaxf(m, mx);
    const float alpha = __builtin_amdgcn_exp2f(m - mn);
    m = mn;
    float rs = 0.f;
#pragma unroll
    for (int i = 0; i < 16; ++i) {
      const float pe = ((okm >> i) & 1u) ? __builtin_amdgcn_exp2f(S[i] - mn) : 0.f;
      S[i] = pe; rs += pe;
    }
    l = l * alpha + rs;
#pragma unroll
    for (int dt = 0; dt < HD / 32; ++dt)
#pragma unroll
      for (int i = 0; i < 16; ++i) O[dt][i] *= alpha;
#pragma unroll
    for (int s = 0; s < 2; ++s) {
      u32x4 pw;
#pragma unroll
      for (int q = 0; q < 4; ++q) pw[q] = pack2(S[8 * s + 2 * q], S[8 * s + 2 * q + 1]);
      const bf16x8 pf = __builtin_bit_cast(bf16x8, pw);
#pragma unroll
      for (int dt = 0; dt < HD / 32; ++dt) {
        O[dt] = MFMA32(vfr[s][dt], pf, O[dt]);
      }
    }
  }
  const float lt = l + __shfl_xor(l, 32);
  const float inv = 1.f / lt;
  const size_t row = (size_t)((s0 + lr) * dil + res);
  if (!EVEN) { if (lh == 0) lse_b[row * 8] = m + __log2f(lt); }
#pragma unroll
  for (int dt = 0; dt < HD / 32; ++dt)
#pragma unroll
    for (int gi = 0; gi < 4; ++gi) {
      const int dim4 = dt * 32 + 8 * gi + 4 * lh;
      float v[4];
#pragma unroll
      for (int k = 0; k < 4; ++k) v[k] = O[dt][4 * gi + k] * inv;
      if (EVEN) {
        const u32x2 gw = *(const u32x2*)(Gb + row * gs + dim4);
        v[0] *= silu(bflo(gw[0])); v[1] *= silu(bfhi(gw[0])); v[2] *= silu(bflo(gw[1])); v[3] *= silu(bfhi(gw[1]));
      }
      store4bf(Ob + row * os + dim4, v);
    }
}

template <int HD, bool EVEN>
DI void attn_wave_db(const bf16_t* __restrict__ Qb, int qs, const bf16_t* __restrict__ KFb,
                  const bf16_t* __restrict__ VFb, int Ls, int dil, int res, int s0, int R,
                  float m_init, float l_init, bf16_t* __restrict__ Ob, int os,
                  const bf16_t* __restrict__ Gb, int gs, float* __restrict__ lse_b) {
  const int lane = otid() & 63, lr = lane & 31, lh = lane >> 5;
  constexpr bool QREG = true;
  bf16x8 qf[QREG ? HD / 16 : 1];
  const bf16_t* qp = Qb + (size_t)((s0 + lr) * dil + res) * qs + lh * 8;
  if (QREG) {
#pragma unroll
    for (int ks = 0; ks < HD / 16; ++ks) qf[ks] = *(const bf16x8*)(qp + ks * 16);
  }
  f32x16 O[HD / 32];
#pragma unroll
  for (int dt = 0; dt < HD / 32; ++dt)
#pragma unroll
    for (int i = 0; i < 16; ++i) O[dt][i] = 0.f;
  float m = m_init;
  float l = (lh == 0) ? l_init : 0.f;
  const int qq = s0 + lr;
  constexpr int KS = HD / 16, DT = HD / 32;
  auto kvload = [&](bf16x8 (&kf)[KS], bf16x8 (&vfr)[2][DT], int kb) {
    const bf16_t* kp = KFb + ((size_t)(kb >> 5) * KS * 64 + lane) * 8;
    const bf16_t* vp = VFb + ((size_t)(kb >> 5) * DT * 2 * 64 + lane) * 8;
#pragma unroll
    for (int ks = 0; ks < KS; ++ks) kf[ks] = *(const bf16x8*)(kp + ks * 512);
#pragma unroll
    for (int dt = 0; dt < DT; ++dt)
#pragma unroll
      for (int s2 = 0; s2 < 2; ++s2) vfr[s2][dt] = *(const bf16x8*)(vp + (dt * 2 + s2) * 512);
  };
  auto step = [&](const bf16x8 (&kf)[KS], const bf16x8 (&vfr)[2][DT], int kb) {
    f32x16 S;
#pragma unroll
    for (int i = 0; i < 16; ++i) S[i] = 0.f;
#pragma unroll
    for (int ks = 0; ks < HD / 16; ++ks) S = MFMA32(kf[ks], qf[ks], S);
    float mx = -1e30f;
    unsigned okm = 0;
    const bool interior = (kb >= s0 + 31 - R) && (kb <= s0 + R - 31);
    if (interior) {
      okm = 0xFFFFu;
#pragma unroll
      for (int i = 0; i < 16; ++i) mx = fmaxf(mx, S[i]);
    } else {
#pragma unroll
      for (int i = 0; i < 16; ++i) {
        const int kk = kb + 16 * lh + i;
        const bool ok = (unsigned)(kk - qq + R) <= (unsigned)(2 * R);
        okm |= ok ? (1u << i) : 0u;
        S[i] = ok ? S[i] : -1e30f;
        mx = fmaxf(mx, S[i]);
      }
    }
    mx = xhalf_max(mx);
    const float mn = fmaxf(m, mx);
    const float alpha = __builtin_amdgcn_exp2f(m - mn);
    m = mn;
    float rs = 0.f;
#pragma unroll
    for (int i = 0; i < 16; ++i) {
      const float pe = ((okm >> i) & 1u) ? __builtin_amdgcn_exp2f(S[i] - mn) : 0.f;
      S[i] = pe; rs += pe;
    }
    l = l * alpha + rs;
#pragma unroll
    for (int dt = 0; dt < HD / 32; ++dt)
#pragma unroll
      for (int i = 0; i < 16; ++i) O[dt][i] *= alpha;
#pragma unroll
    for (int s = 0; s < 2; ++s) {
      u32x4 pw;
#pragma unroll
      for (int q = 0; q < 4; ++q) pw[q] = pack2(S[8 * s + 2 * q], S[8 * s + 2 * q + 1]);
      const bf16x8 pf = __builtin_bit_cast(bf16x8, pw);
#pragma unroll
      for (int dt = 0; dt < HD / 32; ++dt) {
        O[dt] = MFMA32(vfr[s][dt], pf, O[dt]);
      }
    }
  };
  const int kb_lo = s0 - R < 0 ? 0 : s0 - R;
  const int kb_hi = s0 + R > Ls - 32 ? Ls - 32 : s0 + R;
  {
    bf16x8 kA[KS], vA[2][DT], kB[KS], vB[2][DT];
    kvload(kA, vA, kb_lo);
    for (int kb = kb_lo; kb <= kb_hi; kb += 64) {
      kvload(kB, vB, kb + 32 <= kb_hi ? kb + 32 : kb_hi);
      step(kA, vA, kb);
      if (kb + 32 <= kb_hi) {
        kvload(kA, vA, kb + 64 <= kb_hi ? kb + 64 : kb_hi);
        step(kB, vB, kb + 32);
      }
    }
  }
  const float lt = l + __shfl_xor(l, 32);
  const float inv = 1.f / lt;
  const size_t row = (size_t)((s0 + lr) * dil + res);
  if (!EVEN) { if (lh == 0) lse_b[row * 8] = m + __log2f(lt); }
#pragma unroll
  for (int dt = 0; dt < HD / 32; ++dt)
#pragma unroll
    for (int gi = 0; gi < 4; ++gi) {
      const int dim4 = dt * 32 + 8 * gi + 4 * lh;
      float v[4];
#pragma unroll
      for (int k = 0; k < 4; ++k) v[k] = O[dt][4 * gi + k] * inv;
      if (EVEN) {
        const u32x2 gw = *(const u32x2*)(Gb + row * gs + dim4);
        v[0] *= silu(bflo(gw[0])); v[1] *= silu(bfhi(gw[0])); v[2] *= silu(bflo(gw[1])); v[3] *= silu(bfhi(gw[1]));
      }
      store4bf(Ob + row * os + dim4, v);
    }
}

DI void attn_even_job(const Params& p, int li, int bj) {
  const int wave = __builtin_amdgcn_readfirstlane(otid() >> 6);
  const int qt = bj >> 1, kvh = bj & 1;
  const int head = kvh * 4 + wave;
  const int tok0 = qt * 32;
  const int ss = seq_start_of(tok0);
  const int L = tok0 < 16384 ? 16384 : 4096;
  const bf16_t* Q = (const bf16_t*)(p.R + Q_OFF) + (size_t)ss * 512 + head * 64;
  const bf16_t* Kk = (const bf16_t*)(p.R + K_OFF) + ((size_t)kvh * NT + ss) * 64;
  const bf16_t* VT = (const bf16_t*)(p.R + VT_OFF) + ((size_t)kvh * NT + ss) * 64;
  bf16_t* Ob = (bf16_t*)(p.R + ATO_OFF) + (size_t)ss * 512 + head * 64;
  const bf16_t* Gb = (const bf16_t*)(p.R + AG_OFF) + (size_t)ss * 512 + head * 64;
  const float sink2 = p.sink[li * 8 + head] * LOG2E;
  attn_wave_db<64, true>(Q, 512, Kk, VT, L, 1, 0, tok0 - ss, 128, sink2, 1.f, Ob, 512, Gb, 512, nullptr);
}

DI void attn_odd_job(const Params& p, int ch, int bj) {
  const int wave = __builtin_amdgcn_readfirstlane(otid() >> 6);
  const int wj = bj * 4 + wave;
  const int g = wj >> 12, rem = wj & 4095;
  const int head = rem >> 9, tix = rem & 511;
  const int L = ch == 0 ? 16384 : 4096;
  const int sh = g == 0 ? 0 : (g == 1 ? 2 : 4);
  const int Ls = L >> sh;
  const int seqoff = (tix * 32) & ~(L - 1);
  const int w = tix * 32 - seqoff;
  const int r = w / Ls, s0 = w % Ls;
  const bf16_t* Q = (const bf16_t*)(p.R + QO_OFF) + ((size_t)g * CH + seqoff) * 1024 + head * 128;
  const bf16_t* Kk = (const bf16_t*)(p.R + KO_OFF) + (((size_t)g * 8 + head) * CH + seqoff + (size_t)r * Ls) * 128;
  const bf16_t* VT = (const bf16_t*)(p.R + VTO_OFF) + (((size_t)g * 8 + head) * CH + seqoff + (size_t)r * Ls) * 128;
  bf16_t* Ob = (bf16_t*)(p.R + OG_OFF) + ((size_t)g * CH + seqoff) * 1024 + head * 128;
  float* lse = (float*)(p.R + LSE_OFF) + ((size_t)g * CH + seqoff) * 8 + head;
  attn_wave<128, false>(Q, 1024, Kk, VT, Ls, 1 << sh, r, s0, 64, -1e30f, 0.f, Ob, 1024, nullptr, 0, lse);
}

DI void merge_phase(const Params& p, int ch) {
  const bf16_t* Og = (const bf16_t*)(p.R + OG_OFF);
  const float* lse = (const float*)(p.R + LSE_OFF);
  const bf16_t* Go = (const bf16_t*)(p.R + GO_OFF) + (size_t)(ch & 1) * CH * 1024;
  bf16_t* Y = (bf16_t*)(p.R + Y_OFF);
  for (int it = blockIdx.x * 256 + threadIdx.x; it < CH * 128; it += gridDim.x * 256) {
    const int tok = it >> 7, within = it & 127;
    const int head = within >> 4;
    const size_t off = (size_t)tok * 1024 + within * 8;
    float l0 = lse[(size_t)tok * 8 + head], l1 = lse[((size_t)CH + tok) * 8 + head], l2 = lse[((size_t)2 * CH + tok) * 8 + head];
    const float mx = fmaxf(l0, fmaxf(l1, l2));
    float w0 = __builtin_amdgcn_exp2f(l0 - mx), w1 = __builtin_amdgcn_exp2f(l1 - mx), w2 = __builtin_amdgcn_exp2f(l2 - mx);
    const float iv = 1.f / (w0 + w1 + w2);
    w0 *= iv; w1 *= iv; w2 *= iv;
    const u32x4 a = *(const u32x4*)(Og + off);
    const u32x4 b = *(const u32x4*)(Og + (size_t)CH * 1024 + off);
    const u32x4 c = *(const u32x4*)(Og + (size_t)2 * CH * 1024 + off);
    const u32x4 gg = *(const u32x4*)(Go + off);
    u32x4 y;
#pragma unroll
    for (int q = 0; q < 4; ++q) {
      const float lo = (w0 * bflo(a[q]) + w1 * bflo(b[q]) + w2 * bflo(c[q])) * silu(bflo(gg[q]));
      const float hi = (w0 * bfhi(a[q]) + w1 * bfhi(b[q]) + w2 * bfhi(c[q])) * silu(bfhi(gg[q]));
      y[q] = pack2(lo, hi);
    }
    *(u32x4*)(Y + off) = y;
  }
}

struct __attribute__((aligned(4))) U4a { unsigned v[4]; };

DI void sc4(const bf16_t* __restrict__ Uc, int n4, int lmask, float w0, float w1, float w2, float b, float (&o)[4]) {
  const u32x2 w = *(const u32x2*)(Uc + n4);
  const float u0 = bflo(w[0]), u1 = bfhi(w[0]), u2 = bflo(w[1]), u3 = bfhi(w[1]);
  const float um = (n4 & lmask) ? bf2f(Uc[n4 - 1]) : 0.f;
  const float up = ((n4 + 4) & lmask) ? bf2f(Uc[n4 + 4]) : 0.f;
  o[0] = w0 * um + w1 * u0 + w2 * u1 + b;
  o[1] = w0 * u0 + w1 * u1 + w2 * u2 + b;
  o[2] = w0 * u1 + w1 * u2 + w2 * u3 + b;
  o[3] = w0 * u2 + w1 * u3 + w2 * up + b;
}

template <bool SAMPLE>
DI void hyena_job(const Params& p, int li, int c, int grp, char* smem) {
  bf16_t* zl = (bf16_t*)smem;
  const int tid = otid(), lane = tid & 63, wave = __builtin_amdgcn_readfirstlane(tid >> 6), lr = lane & 31, lh = lane >> 5;
  const int tok0 = grp * 16384;
  constexpr int L = SAMPLE ? 4096 : 16384;
  constexpr int nb = L >> 6, lmask = L - 1;
  constexpr int PAD = SAMPLE ? 16 : 32;
  constexpr int SEQB = nb + 2 * PAD + (SAMPLE ? 8 : 0);
  constexpr int LSH = SAMPLE ? 12 : 14;
  const bf16_t* U = (const bf16_t*)(p.R + U_OFF);
  const bf16_t* Uv = U + (size_t)(1024 + c) * NT + tok0;
  const bf16_t* Ux1 = U + (size_t)c * NT + tok0;
  const bf16_t* Ux2 = U + (size_t)(512 + c) * NT + tok0;
  const bf16_t* HGc = (const bf16_t*)(p.R + HG_OFF) + (size_t)c * NT + tok0;
  bf16_t* HYC = (bf16_t*)(p.R + MIX_OFF) + (size_t)c * NT + tok0;
  const float* cw = p.a_conv_w + li * 3 * 1536;
  const float* cb = p.a_conv_b + li * 1536;
  __syncthreads();
  {
    constexpr int NSEQ = SAMPLE ? 4 : 1;
    for (int e = tid; e < NSEQ * 2 * PAD * 8; e += 256) {
      const int q = e / (2 * PAD * 8), r = e - q * (2 * PAD * 8);
      const int pb = r >> 3, part = r & 7;
      const int blk = q * SEQB + (pb < PAD ? pb : nb + pb);
      unsigned zu = 0u;
      asm volatile("" : "+v"(zu));
      u32x4 z; z[0] = zu; z[1] = zu; z[2] = zu; z[3] = zu;
      *(u32x4*)(zl + blk * 72 + part * 8) = z;
    }
    const float w0 = cw[1024 + c], w1 = cw[1536 + 1024 + c], w2 = cw[2 * 1536 + 1024 + c], b = cb[1024 + c];
    for (int n8 = tid; n8 < 2048; n8 += 256) {
      const int n = n8 * 8;
      float o0[4], o1[4];
      sc4(Uv, n, lmask, w0, w1, w2, b, o0);
      sc4(Uv, n + 4, lmask, w0, w1, w2, b, o1);
      u32x4 w; w[0] = pack2(o0[0], o0[1]); w[1] = pack2(o0[2], o0[3]); w[2] = pack2(o1[0], o1[1]); w[3] = pack2(o1[2], o1[3]);
      *(u32x4*)(zl + ((n >> LSH) * SEQB + PAD + ((n & lmask) >> 6)) * 72 + (n & 63)) = w;
    }
  }
  __syncthreads();
  constexpr size_t gstr = SAMPLE ? GSTR_S : GSTR_P;
  constexpr int span = SAMPLE ? 8 : 32;
  constexpr int DSH = span;
  constexpr int CTO = 0;
  constexpr int ctstep = DSH + CTO;
  const int i0w = SAMPLE ? 16 * wave : 64 * wave;
  const int sblk = (SAMPLE ? (lr >> 3) * SEQB : 0) + PAD;
  const int ilane = i0w + (SAMPLE ? (lr & 7) : lr);
  const int dlo = i0w - nb + 1;
  const int dhi = (i0w + DSH + span - 1 < nb - 1) ? i0w + DSH + span - 1 : nb - 1;
  for (int o = 0; o < 2; ++o) {
    const bf16_t* GA = (const bf16_t*)(p.R + (SAMPLE ? GAS_OFF : GAP_OFF)) + (size_t)(o * 512 + c) * gstr;
    const bf16_t* GB = (const bf16_t*)(p.R + (SAMPLE ? GBS_OFF : GBP_OFF)) + (size_t)(o * 512 + c) * gstr;
    const bf16_t* gbase = ((lr & 1) ? GB - 1 : GA) + (L - 32 - lr + 8 * lh);
    f32x16 acc[2][2];
#pragma unroll
    for (int a = 0; a < 2; ++a)
#pragma unroll
      for (int b = 0; b < 2; ++b)
#pragma unroll
        for (int i = 0; i < 16; ++i) acc[a][b][i] = 0.f;
    auto fload = [&](U4a (&P)[6], int d) {
      const int dc = d <= dhi ? d : dhi;
#pragma unroll
      for (int q = 0; q < 6; ++q) P[q] = *(const U4a*)(gbase - 64 * dc + 16 * q);
    };
    auto fcomp = [&](const U4a (&P)[6], int d) {
      if (d > dhi) return;
#pragma unroll
      for (int ct = 0; ct < 2; ++ct) {
        const int i0 = i0w + DSH * ct;
        const int lo_ = i0 - nb + 1, hi_ = (i0 + span - 1 < nb - 1) ? i0 + span - 1 : nb - 1;
        if (d < lo_ || d > hi_) continue;
        const int jb = ilane + DSH * ct - d;
        const bf16_t* zp = zl + (sblk + CTO * ct + jb) * 72 + 8 * lh;
#pragma unroll
        for (int ks = 0; ks < 4; ++ks) {
          const bf16x8 bfr = *(const bf16x8*)(zp + 16 * ks);
#pragma unroll
          for (int rt = 0; rt < 2; ++rt) acc[rt][ct] = MFMA32(__builtin_bit_cast(bf16x8, P[2 - 2 * rt + ks]), bfr, acc[rt][ct]);
        }
      }
    };
    auto fload4 = [&](U4a (&P)[6], int d) {
      const int dc = d <= dhi ? d : dhi;
#pragma unroll
      for (int q = 0; q < 4; ++q) P[q] = *(const U4a*)(gbase - 64 * dc + 16 * q);
    };
    U4a PA[6], PB[6];
    fload(PA, dlo);
    for (int d = dlo; d <= dhi; d += 2) {
      fload4(PB, d + 1);
      fcomp(PA, d);
      PB[4] = PA[0]; PB[5] = PA[1];
      fload4(PA, d + 2);
      fcomp(PB, d + 1);
      PA[4] = PB[0]; PA[5] = PB[1];
    }
    const float dco = p.hyd[li * 1024 + o * 512 + c];
    const int zoff = (sblk + ilane) * 72 + 4 * lh;
#pragma unroll
    for (int rt = 0; rt < 2; ++rt)
#pragma unroll
      for (int ct = 0; ct < 2; ++ct)
#pragma unroll
        for (int gi = 0; gi < 4; ++gi) {
          const u32x2 zw = *(const u32x2*)(zl + zoff + ct * ctstep * 72 + 32 * rt + 8 * gi);
          acc[rt][ct][4 * gi + 0] += dco * bflo(zw[0]); acc[rt][ct][4 * gi + 1] += dco * bfhi(zw[0]);
          acc[rt][ct][4 * gi + 2] += dco * bflo(zw[1]); acc[rt][ct][4 * gi + 3] += dco * bfhi(zw[1]);
        }
    __syncthreads();
#pragma unroll
    for (int rt = 0; rt < 2; ++rt)
#pragma unroll
      for (int ct = 0; ct < 2; ++ct)
#pragma unroll
        for (int gi = 0; gi < 4; ++gi) {
          u32x2 w; w[0] = pack2(acc[rt][ct][4 * gi + 0], acc[rt][ct][4 * gi + 1]); w[1] = pack2(acc[rt][ct][4 * gi + 2], acc[rt][ct][4 * gi + 3]);
          *(u32x2*)(zl + zoff + ct * ctstep * 72 + 32 * rt + 8 * gi) = w;
        }
    __syncthreads();
    {
      const bf16_t* Ug = o == 0 ? Ux1 : Ux2;
      const int gch = o == 0 ? c : 512 + c;
      const float w0 = cw[gch], w1 = cw[1536 + gch], w2 = cw[2 * 1536 + gch], b = cb[gch];
#pragma unroll 1
      for (int n8 = tid; n8 < 2048; n8 += 256) {
        const int n = n8 * 8;
        float g0[4], g1[4];
        sc4(Ug, n, lmask, w0, w1, w2, b, g0);
        sc4(Ug, n + 4, lmask, w0, w1, w2, b, g1);
        bf16_t* zp = zl + ((n >> LSH) * SEQB + PAD + ((n & lmask) >> 6)) * 72 + (n & 63);
        const u32x4 zw = *(const u32x4*)zp;
        float v[8];
        v[0] = g0[0] * bflo(zw[0]); v[1] = g0[1] * bfhi(zw[0]); v[2] = g0[2] * bflo(zw[1]); v[3] = g0[3] * bfhi(zw[1]);
        v[4] = g1[0] * bflo(zw[2]); v[5] = g1[1] * bfhi(zw[2]); v[6] = g1[2] * bflo(zw[3]); v[7] = g1[3] * bfhi(zw[3]);
        if (o == 0) {
          u32x4 w; w[0] = pack2(v[0], v[1]); w[1] = pack2(v[2], v[3]); w[2] = pack2(v[4], v[5]); w[3] = pack2(v[6], v[7]);
          *(u32x4*)zp = w;
        } else {
          const u32x4 gw = *(const u32x4*)(HGc + n);
          u32x4 w;
          w[0] = pack2(v[0] * silu(bflo(gw[0])), v[1] * silu(bfhi(gw[0])));
          w[1] = pack2(v[2] * silu(bflo(gw[1])), v[3] * silu(bfhi(gw[1])));
          w[2] = pack2(v[4] * silu(bflo(gw[2])), v[5] * silu(bfhi(gw[2])));
          w[3] = pack2(v[6] * silu(bflo(gw[3])), v[7] * silu(bfhi(gw[3])));
          *(u32x4*)(HYC + n) = w;
        }
      }
    }
    __syncthreads();
  }
}

DI void final_phase(const Params& p) {
  const int lane = threadIdx.x & 63, wave = __builtin_amdgcn_readfirstlane(threadIdx.x >> 6);
  for (int row = blockIdx.x * 4 + wave; row < NT; row += gridDim.x * 4) {
    float4* xr = (float4*)(p.out + (size_t)row * 1024);
    float4 v[4]; float ss = 0.f;
#pragma unroll
    for (int q = 0; q < 4; ++q) { v[q] = xr[q * 64 + lane]; ss += v[q].x * v[q].x + v[q].y * v[q].y + v[q].z * v[q].z + v[q].w * v[q].w; }
#pragma unroll
    for (int o = 32; o >= 1; o >>= 1) ss += __shfl_xor(ss, o);
    const float rstd = rsqrtf(ss * (1.f / 1024.f) + 1e-6f);
#pragma unroll
    for (int q = 0; q < 4; ++q) {
      const float4 g = ((const float4*)p.final_norm)[q * 64 + lane];
      float4 r; r.x = v[q].x * rstd * g.x; r.y = v[q].y * rstd * g.y; r.z = v[q].z * rstd * g.z; r.w = v[q].w * rstd * g.w;
      xr[q * 64 + lane] = r;
    }
  }
}


DI void run_phase(const Params& p, int ph, char* smem) {
  const int bid = obid(), nbk = gridDim.x;
  if (ph == 0) { prep_phase(p, smem); return; }
  if (ph == NPH - 1) { final_phase(p); return; }
  int q = ph - 1, layer, sub;
  if (q < 3) { layer = 0; sub = q; } else if (q < 15) { layer = 1; sub = q - 3; } else if (q < 18) { layer = 2; sub = q - 15; } else { layer = 3; sub = q - 18; }
  const int li = layer >> 1;
  const float* xcp = layer == 0 ? p.xp : p.out;
  const float* xcs = layer == 0 ? p.xs : p.out + (size_t)16384 * 1024;
  if ((layer & 1) == 0) {
    if (sub == 0) {
      const int ngemm = 640 * 26, nfilt = 5120;
      const bf16_t* Wt = p.wt_ain + (size_t)li * 3328 * 1024;
      gemm_run<1, 0>(p, bid, ngemm, nbk, 26, 0, xcp, xcs, nullptr, Wt, smem);
      for (int j = ngemm + ((bid + nbk - (ngemm % nbk)) % nbk); j < ngemm + nfilt; j += nbk) {
        {
          const int f = j - ngemm;
          if (f < 4096) filt_job(p, li, 0, (f >> 5) & 1, f & 31, f >> 6, smem);
          else { const int f2 = f - 4096; filt_job(p, li, 1, (f2 >> 5) & 1, f2 & 31, f2 >> 6, smem); }
        }
      }
    } else if (sub == 1) {
      const int nhy = 2560, natt = 5120;
      for (int j = bid; j < nhy + natt; j += nbk) {
        if (j < nhy) { const int c_ = j < 512 ? j : (j - 512) >> 2; const int g_ = j < 512 ? 0 : 1 + ((j - 512) & 3);
          if (j < 512) hyena_job<false>(p, li, c_, g_, smem); else hyena_job<true>(p, li, c_, g_, smem); }
        else { for (int rep = 0; rep < REP_ATT; ++rep) attn_even_job(p, li, j - nhy); }
      }
    } else {
      const bf16_t* Wt = p.wt_aout + (size_t)li * 1024 * 1024;
      const bf16_t* A = (const bf16_t*)(p.R + MIX_OFF);
      gemm_run<2, 2>(p, bid, 640 * 8, nbk, 8, 0, xcp, xcs, A, Wt, smem);
    }
  } else {
    const bf16_t* Wi = p.wt_cin + (size_t)li * 10240 * 1024;
    const bf16_t* Wo = p.wt_cout + (size_t)li * 1024 * 1024;
    int c1 = -1, c2 = -1, c3 = -1, c4 = -1;
    if (sub == 0) c1 = 0;
    else if (sub == 1) c2 = 0;
    else {
      const int ch = (sub - 2) >> 1;
      if (((sub - 2) & 1) == 0) { c3 = ch; if (ch < 4) c1 = ch + 1; }
      else { c4 = ch; if (ch < 4) c2 = ch + 1; }
    }
    if (c3 >= 0) merge_phase(p, c3);
    if (c4 >= 0) gemm_run<1, 2>(p, bid, 128 * 8, nbk, 8, c4 * CH, xcp, xcs, (const bf16_t*)(p.R + Y_OFF), Wo, smem);
    if (c1 >= 0) gemm_run<1, 1>(p, bid, 128 * 80, nbk, 80, c1 * CH, xcp, xcs, nullptr, Wi, smem);
    if (c2 >= 0) { for (int j = bid; j < 3072; j += nbk) attn_odd_job(p, c2, j); }
  }
}

#if MULTI_LAUNCH
__global__ void __launch_bounds__(256, 2) phase_kernel(Params p, int ph) {
  __shared__ __attribute__((aligned(16))) char smem[74240];
  run_phase(p, ph, smem);
}
#else
__global__ void __launch_bounds__(256, 2) mega_kernel(Params p) {
  __shared__ __attribute__((aligned(16))) char smem[74240];
  __shared__ uint4 xb_words;
  cg::grid_group grid = cg::this_grid();
  if (threadIdx.x == 0) xb_words = make_uint4(0u, 0u, 0u, 0u);
  __syncthreads();
  XcdBarrier xb = xcd_barrier_post(p.bar, (volatile LAS unsigned*)&xb_words);
#pragma unroll 1
  for (int ph = 0; ph < NPH; ++ph) {
    run_phase(p, ph, smem);
    if (p.bar == nullptr) grid.sync();
    if (ph + 1 < NPH) xcd_barrier(xb);
  }
}
#endif

extern "C" void kernel_launch(void* const* d_in, const int* in_sizes, int n_in, void* d_out, int out_size,
                              void* d_ws, size_t ws_size, hipStream_t stream) {
  Params p{};
  p.xp = (const float*)d_in[0]; p.xs = (const float*)d_in[1];
  p.a_norm = (const float*)d_in[2]; p.a_w_in = (const float*)d_in[3]; p.a_conv_w = (const float*)d_in[4]; p.a_conv_b = (const float*)d_in[5];
  p.fw1 = (const float*)d_in[6]; p.fb1 = (const float*)d_in[7]; p.ff1 = (const float*)d_in[8]; p.fw2 = (const float*)d_in[9];
  p.fb2 = (const float*)d_in[10]; p.ff2 = (const float*)d_in[11]; p.fw3 = (const float*)d_in[12]; p.hyd = (const float*)d_in[13];
  p.sink = (const float*)d_in[14]; p.a_w_out = (const float*)d_in[15]; p.c_norm = (const float*)d_in[16]; p.c_w_in = (const float*)d_in[17];
  p.c_w_out = (const float*)d_in[18]; p.final_norm = (const float*)d_in[19];
  p.out = (float*)d_out;
  char* ws = (char*)d_ws;
  size_t off = 0;
  p.wt_ain = (bf16_t*)(ws + off); off += (size_t)2 * 3328 * 1024 * 2;
  p.wt_cin = (bf16_t*)(ws + off); off += (size_t)2 * 10240 * 1024 * 2;
  p.wt_aout = (bf16_t*)(ws + off); off += (size_t)2 * 1024 * 1024 * 2;
  p.wt_cout = (bf16_t*)(ws + off); off += (size_t)2 * 1024 * 1024 * 2;
  p.hid = (float*)(ws + off); off += (size_t)2 * HID_PER_LAYER * 4;
  p.bar = (unsigned*)(ws + off); off += 16384;
  p.R = ws + off;
  const size_t need = off + (EVEN_END > ODD_END ? EVEN_END : ODD_END);
  if (need > ws_size) { fprintf(stderr, "workspace too small: need %zu have %zu\n", need, ws_size); return; }
#if MULTI_LAUNCH
  for (int ph = 0; ph < NPH; ++ph) hipLaunchKernelGGL(phase_kernel, dim3(1024), dim3(256), 0, stream, p, ph);
#else
  static int grid_blocks = 0;
  if (!grid_blocks) {
    int dev = 0, cus = 0, per_cu = 0;
    (void)hipGetDevice(&dev);
    (void)hipDeviceGetAttribute(&cus, hipDeviceAttributeMultiprocessorCount, dev);
    (void)hipOccupancyMaxActiveBlocksPerMultiprocessor(&per_cu, mega_kernel, 256, 0);
    if (per_cu < 1) per_cu = 1;
    if (per_cu > 2) per_cu = 2;
    grid_blocks = cus * per_cu;
  }
  (void)hipMemsetAsync(p.bar, 0, XCD_BAR_WORDS * 4, stream);
  void* args[] = {&p};
  hipError_t e = hipLaunchCooperativeKernel((void*)mega_kernel, dim3(grid_blocks), dim3(256), args, 0, stream);
  if (e != hipSuccess) fprintf(stderr, "cooperative launch failed: %s (grid %d)\n", hipGetErrorString(e), grid_blocks);
#endif
}
```

```cpp
#include <hip/hip_runtime.h>
#include <hip/hip_cooperative_groups.h>
#include <cstdio>
namespace cg = cooperative_groups;

typedef __attribute__((ext_vector_type(8))) short bf16x8;
typedef __attribute__((ext_vector_type(16))) float f32x16;
typedef __attribute__((ext_vector_type(4))) float f32x4;
typedef __attribute__((ext_vector_type(4))) unsigned u32x4;
typedef __attribute__((ext_vector_type(2))) unsigned u32x2;
typedef unsigned short bf16_t;

#define DI __device__ __forceinline__
#define MFMA32(a, b, c) __builtin_amdgcn_mfma_f32_32x32x16_bf16((a), (b), (c), 0, 0, 0)

#ifndef REP_GIN
#define REP_GIN 1
#endif
#ifndef REP_HY
#define REP_HY 1
#endif
#ifndef REP_ATT
#define REP_ATT 1
#endif
#ifndef REP_FILT
#define REP_FILT 1
#endif
#ifndef MULTI_LAUNCH
#define MULTI_LAUNCH 0
#endif

static constexpr int NT = 81920;
static constexpr int CH = 16384;
static constexpr int NPH = 32;
static constexpr float LOG2E = 1.4426950408889634f;
static constexpr int HID_PER_LAYER = 64 * 16384 + 64 * 4096;

static constexpr size_t U_OFF = 0;
static constexpr size_t HG_OFF = U_OFF + (size_t)1536 * NT * 2;
static constexpr size_t Q_OFF = HG_OFF + (size_t)512 * NT * 2;
static constexpr size_t K_OFF = Q_OFF + (size_t)NT * 512 * 2;
static constexpr size_t VT_OFF = K_OFF + (size_t)NT * 128 * 2;
static constexpr size_t AG_OFF = VT_OFF + (size_t)128 * NT * 2;
static constexpr size_t GSTR_P = 2 * 16384 + 8;
static constexpr size_t GSTR_S = 2 * 4096 + 8;
static constexpr size_t GAP_OFF = AG_OFF + (size_t)NT * 512 * 2;
static constexpr size_t GBP_OFF = GAP_OFF + (size_t)1024 * GSTR_P * 2;
static constexpr size_t GAS_OFF = GBP_OFF + (size_t)1024 * GSTR_P * 2;
static constexpr size_t GBS_OFF = GAS_OFF + (size_t)1024 * GSTR_S * 2;
static constexpr size_t MIX_OFF = (GBS_OFF + (size_t)1024 * GSTR_S * 2 + 255) & ~(size_t)255;
static constexpr size_t ATO_OFF = MIX_OFF + (size_t)512 * NT * 2;
static constexpr size_t XBE_OFF = MIX_OFF;
static constexpr size_t EVEN_END = MIX_OFF + (size_t)NT * 1024 * 2;
static constexpr size_t XB_OFF = 0;
static constexpr size_t QO_OFF = (size_t)NT * 1024 * 2;
static constexpr size_t KO_OFF = QO_OFF + (size_t)3 * CH * 1024 * 2;
static constexpr size_t VTO_OFF = KO_OFF + (size_t)3 * CH * 1024 * 2;
static constexpr size_t GO_OFF = VTO_OFF + (size_t)3 * CH * 1024 * 2;
static constexpr size_t OG_OFF = GO_OFF + (size_t)2 * CH * 1024 * 2;
static constexpr size_t LSE_OFF = OG_OFF + (size_t)3 * CH * 1024 * 2;
static constexpr size_t Y_OFF = LSE_OFF + (size_t)3 * CH * 8 * 4;
static constexpr size_t ODD_END = Y_OFF + (size_t)CH * 1024 * 2;

struct Params {
  const float *xp, *xs;
  const float *a_norm, *a_w_in, *a_conv_w, *a_conv_b, *fw1, *fb1, *ff1, *fw2, *fb2, *ff2, *fw3, *hyd, *sink, *a_w_out;
  const float *c_norm, *c_w_in, *c_w_out, *final_norm;
  float* out;
  bf16_t *wt_ain, *wt_cin, *wt_aout, *wt_cout;
  float* hid;
  char* R;
  unsigned* bar;
};

DI unsigned short f2bf(float x) { unsigned u = __float_as_uint(x); u += 0x7fffu + ((u >> 16) & 1u); return (unsigned short)(u >> 16); }
DI float bf2f(unsigned short b) { return __uint_as_float(((unsigned)b) << 16); }
DI unsigned pack2(float a, float b) { unsigned r; asm("v_cvt_pk_bf16_f32 %0, %1, %2" : "=v"(r) : "v"(a), "v"(b)); return r; }
DI float bflo(unsigned w) { return __uint_as_float(w << 16); }
DI float bfhi(unsigned w) { return __uint_as_float(w & 0xffff0000u); }
typedef __attribute__((ext_vector_type(2))) __bf16 bf2_t;
DI float dot2sq(unsigned w, float c) { const bf2_t v = __builtin_bit_cast(bf2_t, w); return __builtin_amdgcn_fdot2_f32_bf16(v, v, c, false); }
DI float xhalf_max(float x) { const unsigned u = __float_as_uint(x); auto r = __builtin_amdgcn_permlane32_swap(u, u, false, false); return fmaxf(__uint_as_float(r[0]), __uint_as_float(r[1])); }
DI float dpp_f(float x, int ctrl_sel) {
  const int b = __float_as_int(x);
  return __int_as_float(ctrl_sel == 0 ? __builtin_amdgcn_update_dpp(0, b, 0xB1, 0xF, 0xF, true)
                       : ctrl_sel == 1 ? __builtin_amdgcn_update_dpp(0, b, 0x4E, 0xF, 0xF, true)
                                       : __builtin_amdgcn_update_dpp(0, b, 0x141, 0xF, 0xF, true));
}
DI int otid() { int t = threadIdx.x; asm volatile("" : "+v"(t)); return t; }
DI int obid() { int t = blockIdx.x; asm volatile("" : "+s"(t)); return t; }
DI int seq_start_of(int tok) { return tok < 16384 ? 0 : (16384 + ((tok - 16384) & ~4095)); }
DI float silu(float x) { return x / (1.f + __expf(-x)); }
DI void store4bf(bf16_t* dst, const float (&v)[4]) { u32x2 w; w[0] = pack2(v[0], v[1]); w[1] = pack2(v[2], v[3]); *(u32x2*)dst = w; }


#define XB_TMO      128
#define XB_XCNT(j)  (256  + 64 * (j))
#define XB_XSUB(j)  (1280 + 64 * (j))
#define XB_XGEN(j)  (2304 + 64 * (j))
#define XB_TOP      3328
#define XB_TOPGEN   3392
#define XCD_BAR_WORDS 3456
#define XB_SPIN_CAP (1u << 22)
#define LAS __attribute__((address_space(3)))
DI unsigned xb_ld(unsigned* p) { return __hip_atomic_load(p, __ATOMIC_RELAXED, __HIP_MEMORY_SCOPE_AGENT); }
DI unsigned xb_add(unsigned* p, unsigned v) { return __hip_atomic_fetch_add(p, v, __ATOMIC_RELAXED, __HIP_MEMORY_SCOPE_AGENT); }
DI unsigned xb_xcc_id() { return (unsigned)__builtin_amdgcn_s_getreg((3 << 11) | 20) & 0xFu; }
#define XB_SPIN(cond, bar) do { unsigned _sp = 0; while (cond) { __builtin_amdgcn_s_sleep(1); \
    if ((++_sp & 255u) == 0u) { if (xb_ld(&(bar)[XB_TMO])) break; if (_sp > XB_SPIN_CAP) { atomicAdd(&(bar)[XB_TMO], 1u); break; } } } } while (0)
struct XcdBarrier { unsigned* bar; unsigned x; volatile LAS unsigned* st; };
DI XcdBarrier xcd_barrier_post(unsigned* bar, volatile LAS unsigned* st) {
  XcdBarrier b; b.bar = bar; b.x = xb_xcc_id(); b.st = st;
  if (threadIdx.x == 0) (void)xb_add(&bar[XB_XCNT(b.x)], 1u);
  return b;
}
DI void xcd_barrier_complete(unsigned* bar, unsigned x, unsigned& nloc, unsigned& nx) {
  const unsigned G = gridDim.x * gridDim.y * gridDim.z;
  unsigned sum, cnt, mine, sp = 0u;
  for (;;) {
    sum = 0u; cnt = 0u; mine = 0u;
#pragma unroll
    for (unsigned j = 0; j < 16; ++j) { const unsigned c = xb_ld(&bar[XB_XCNT(j)]); sum += c; cnt += (c > 0u) ? 1u : 0u; mine = (j == x) ? c : mine; }
    if (sum == G) break;
    __builtin_amdgcn_s_sleep(1);
    if ((++sp & 255u) == 0u) { if (xb_ld(&bar[XB_TMO])) break; if (sp > XB_SPIN_CAP) { atomicAdd(&bar[XB_TMO], 1u); break; } }
  }
  nloc = mine > 0u ? mine : 1u; nx = cnt > 0u ? cnt : 1u;
}
DI void xcd_barrier(const XcdBarrier& b) {
  asm volatile("s_waitcnt vmcnt(0)" ::: "memory");
  __syncthreads();
  if (threadIdx.x == 0) {
    unsigned* bar = b.bar;
    __builtin_amdgcn_s_waitcnt(0);
    unsigned nloc = b.st[0], nx = b.st[1];
    if (nloc == 0u) { xcd_barrier_complete(bar, b.x, nloc, nx); b.st[0] = nloc; b.st[1] = nx; }
    const unsigned old = xb_add(&bar[XB_XSUB(b.x)], 1u);
    const unsigned gen = old / nloc;
    if (old + 1u == (gen + 1u) * nloc) {
      __builtin_amdgcn_fence(__ATOMIC_RELEASE, "agent");
      asm volatile("s_waitcnt vmcnt(0)" ::: "memory");
      const unsigned og = xb_add(&bar[XB_TOP], 1u);
      const unsigned tg = og / nx;
      if (og + 1u == (tg + 1u) * nx) xb_add(&bar[XB_TOPGEN], 1u);
      else XB_SPIN(xb_ld(&bar[XB_TOPGEN]) == tg, bar);
      __builtin_amdgcn_fence(__ATOMIC_ACQUIRE, "agent");
      xb_add(&bar[XB_XGEN(b.x)], 1u);
      asm volatile("s_waitcnt vmcnt(0)" ::: "memory");
    } else {
      XB_SPIN(xb_ld(&bar[XB_XGEN(b.x)]) == gen, bar);
      __builtin_amdgcn_fence(__ATOMIC_ACQUIRE, "agent");
      asm volatile("s_waitcnt vmcnt(0)" ::: "memory");
    }
  }
  __syncthreads();
}

DI void prep_phase(const Params& p, char* smem) {
  const int tid = threadIdx.x;
  for (int m = 0; m < 8; ++m) {
    const float* W; const float* g = nullptr; bf16_t* Wt; int N;
    const int i = m & 1;
    if (m < 2) { N = 3328; W = p.a_w_in + (size_t)i * 1024 * 3328; g = p.a_norm + i * 1024; Wt = p.wt_ain + (size_t)i * 3328 * 1024; }
    else if (m < 4) { N = 10240; W = p.c_w_in + (size_t)i * 1024 * 10240; g = p.c_norm + i * 1024; Wt = p.wt_cin + (size_t)i * 10240 * 1024; }
    else if (m < 6) { N = 1024; W = p.a_w_out + (size_t)i * 1024 * 1024; Wt = p.wt_aout + (size_t)i * 1024 * 1024; }
    else { N = 1024; W = p.c_w_out + (size_t)i * 1024 * 1024; Wt = p.wt_cout + (size_t)i * 1024 * 1024; }
    const int items = N * 128;
    for (int it = blockIdx.x * 256 + tid; it < items; it += gridDim.x * 256) {
      const int n = it % N, kg = it / N;
      float v[8];
#pragma unroll
      for (int j = 0; j < 8; ++j) { const int k = kg * 8 + j; v[j] = W[(size_t)k * N + n] * (g ? g[k] : 1.f); }
      u32x4 w; w[0] = pack2(v[0], v[1]); w[1] = pack2(v[2], v[3]); w[2] = pack2(v[4], v[5]); w[3] = pack2(v[6], v[7]);
      *(u32x4*)(Wt + (size_t)n * 1024 + kg * 8) = w;
    }
  }
  {
    bf16_t* xbe = (bf16_t*)(p.R + XBE_OFF);
    for (int it = blockIdx.x * 256 + tid; it < NT * 128; it += gridDim.x * 256) {
      const size_t e = (size_t)it * 8;
      const float* src = e < (size_t)16384 * 1024 ? p.xp + e : p.xs + (e - (size_t)16384 * 1024);
      const float4 a = *(const float4*)src, b = *(const float4*)(src + 4);
      u32x4 w; w[0] = pack2(a.x, a.y); w[1] = pack2(a.z, a.w); w[2] = pack2(b.x, b.y); w[3] = pack2(b.z, b.w);
      *(u32x4*)(xbe + e) = w;
    }
  }
  float* sF = (float*)smem;
  float* sH = sF + 4 * 36;
  const int tl = tid >> 6, j = tid & 63;
  for (int item = blockIdx.x; item < 2 * 20480 / 4; item += gridDim.x) {
    const int gt = item * 4 + tl;
    const int li = gt / 20480, rem = gt % 20480;
    const int Lidx = rem >= 16384 ? 1 : 0;
    const int t = Lidx ? rem - 16384 : rem;
    const int L = Lidx ? 4096 : 16384;
    if (j < 33) {
      float f;
      if (j == 0) f = (float)t / (float)(L - 1);
      else {
        const int b = (j - 1) & 15;
        const float band = 1e-4f + (float)b * ((15.f - 1e-4f) / 15.f);
        const float wpos = 6.283185307179586f * (float)t / (float)L;
        const float a = band * wpos;
        f = (j <= 16) ? cosf(a) : -sinf(a);
      }
      sF[tl * 36 + j] = f;
    }
    __syncthreads();
    {
      const float* w1 = p.fw1 + li * 33 * 64;
      float a = p.fb1[li * 64 + j];
      for (int e = 0; e < 33; ++e) a += sF[tl * 36 + e] * w1[e * 64 + j];
      sH[tl * 64 + j] = sinf(p.ff1[li * 64 + j] * a);
    }
    __syncthreads();
    {
      const float* w2 = p.fw2 + li * 64 * 64;
      float a = p.fb2[li * 64 + j];
      for (int e = 0; e < 64; ++e) a += sH[tl * 64 + e] * w2[e * 64 + j];
      const float h2 = sinf(p.ff2[li * 64 + j] * a);
      p.hid[(size_t)li * HID_PER_LAYER + (Lidx ? 64 * 16384 : 0) + (size_t)j * L + t] = h2;
    }
    __syncthreads();
  }
}

DI void filt_job(const Params& p, int li, int Lidx, int o, int cg, int tch, char* smem) {
  const int tid = otid();
  const int L = Lidx ? 4096 : 16384;
  const int c0 = cg * 16;
  const float* hid = p.hid + (size_t)li * HID_PER_LAYER + (Lidx ? 64 * 16384 : 0);
  const float* w3 = p.fw3 + (size_t)li * 64 * 2048;
  float* sW = (float*)smem;
  __syncthreads();
  for (int e = tid; e < 64 * 32; e += 256) {
    const int jj = e >> 5, cc = e & 31;
    sW[e] = w3[jj * 2048 + (o * 2 + (cc >> 4)) * 512 + c0 + (cc & 15)];
  }
  __syncthreads();
  const int t = tch * 256 + tid;
  float acc[32];
#pragma unroll
  for (int i = 0; i < 32; ++i) acc[i] = 0.f;
#pragma unroll 4
  for (int jj = 0; jj < 64; ++jj) {
    const float hv = hid[(size_t)jj * L + t];
#pragma unroll
    for (int q = 0; q < 8; ++q) {
      const float4 w = *(const float4*)(sW + jj * 32 + 4 * q);
      acc[4 * q + 0] += hv * w.x; acc[4 * q + 1] += hv * w.y; acc[4 * q + 2] += hv * w.z; acc[4 * q + 3] += hv * w.w;
    }
  }
  const size_t gstr = Lidx ? GSTR_S : GSTR_P;
  bf16_t* GA = (bf16_t*)(p.R + (Lidx ? GAS_OFF : GAP_OFF)) + (size_t)(o * 512 + c0) * gstr;
  bf16_t* GB = (bf16_t*)(p.R + (Lidx ? GBS_OFF : GBP_OFF)) + (size_t)(o * 512 + c0) * gstr;
  const float min_decay = -3.0701134573253945f, max_decay = -15.350567286626973f;
  const float tl = (float)t / (float)(L - 1);
#pragma unroll
  for (int cc = 0; cc < 16; ++cc) {
    const float delta = fabsf(min_decay + (float)(c0 + cc) * ((max_decay - min_decay) / 511.f));
    const float win = expf(-tl * delta) + 0.05f;
    const float f = acc[cc] * win, bk = acc[16 + cc] * win;
    bf16_t* ga = GA + (size_t)cc * gstr;
    bf16_t* gb = GB + (size_t)cc * gstr;
    if (t == 0) {
      const bf16_t v = f2bf(f + bk);
      ga[L] = v; gb[L - 1] = v;
      ga[0] = 0;
    } else {
      const bf16_t vf = f2bf(f), vb = f2bf(bk);
      ga[L - t] = vf; gb[L - t - 1] = vf;
      ga[L + t] = vb; gb[L + t - 1] = vb;
    }
  }
}

template <int HALF>
DI void rope4(float (&v)[4], int lr, int pos0) {
  const int idx = lr & (HALF - 1);
  const float inv = exp2f(-((float)idx / (float)HALF) * 18.931568569324174f);
#pragma unroll
  for (int k = 0; k < 4; ++k) {
    const float pv = __shfl_xor(v[k], HALF);
    const float ang = (float)(pos0 + k) * inv;
    const float n = __builtin_rintf(ang * 0.15915494309189535f);
    float r = __builtin_fmaf(-n, 6.28318548202514648f, ang);
    r = __builtin_fmaf(-n, -1.7484555e-7f, r);
    const float fr = r * 0.15915494309189535f;
    const float s = __builtin_amdgcn_sinf(fr), c = __builtin_amdgcn_cosf(fr);
    if (lr < HALF) v[k] = v[k] * c - pv * s;
    else if (lr < 2 * HALF) v[k] = v[k] * c + pv * s;
  }
}

template <int AMODE, int EPI>
DI void gemm_tile(const Params& p, int mt, int nt, int tok0, const float* xcp, const float* xcs,
                          const bf16_t* Ab, const bf16_t* Wt, char* smem) {
  bf16_t* sAB = (bf16_t*)smem;
  float* sR = (float*)(smem + 2 * 2 * 128 * 72 * 2);
  const int tid = otid(), lane = tid & 63, wave = tid >> 6;
  const int wm = wave >> 1, wn = wave & 1;
  const int lr = lane & 31, lh = lane >> 5;
  const int ar = tid >> 4, ac = (tid & 15) * 4;
  const int br = tid >> 3, bc = (tid & 7) * 8;
  const float* arow_f = nullptr; const bf16_t* arow_b = nullptr;
  if (AMODE == 0) {
    const int tokA = tok0 + mt * 128 + ar;
    arow_f = (tokA < 16384 ? xcp + (size_t)tokA * 1024 : xcs + (size_t)(tokA - 16384) * 1024) + ac;
  } else if (AMODE == 1) {
    arow_b = (EPI == 1 ? (const bf16_t*)(p.R + XB_OFF) + (size_t)tok0 * 1024 : (EPI == 0 ? (const bf16_t*)(p.R + XBE_OFF) + (size_t)tok0 * 1024 : Ab)) + (size_t)(mt * 128 + br) * 1024 + bc;
  } else {
    arow_b = (const bf16_t*)(p.R + MIX_OFF) + (size_t)(tid & 63) * NT + tok0 + mt * 128 + 8 * (tid >> 6);
  }
  const bf16_t* ato_b = (const bf16_t*)(p.R + ATO_OFF) + (size_t)(tok0 + mt * 128 + br) * 512 + bc;
  const bf16_t* brow = Wt + (size_t)(nt * 128 + br) * 1024 + bc;
  f32x16 acc[2][2];
#pragma unroll
  for (int a = 0; a < 2; ++a)
#pragma unroll
    for (int b = 0; b < 2; ++b)
#pragma unroll
      for (int i = 0; i < 16; ++i) acc[a][b][i] = 0.f;
  struct Regs { float4 af[AMODE == 0 ? 8 : 1]; u32x4 ab[AMODE == 0 ? 1 : 4]; u32x4 bb[4]; };
  Regs R0, R1;
  float ssq[8];
#pragma unroll
  for (int i = 0; i < 8; ++i) ssq[i] = 0.f;
  auto gload = [&](Regs& R, int kt_) {
    const int kt = kt_ < 16 ? kt_ : 15;
    const int ko = kt * 64;
    if (AMODE == 0) {
#pragma unroll
      for (int i = 0; i < 8; ++i) R.af[i] = *(const float4*)(arow_f + (size_t)i * 16 * 1024 + ko);
    } else if (AMODE == 1) {
#pragma unroll
      for (int i = 0; i < 4; ++i) R.ab[i] = *(const u32x4*)(arow_b + (size_t)i * 32 * 1024 + ko);
    } else {
      if (kt < 8) {
#pragma unroll
        for (int i = 0; i < 4; ++i) R.ab[i] = *(const u32x4*)(arow_b + (size_t)ko * NT + 32 * i);
      } else {
#pragma unroll
        for (int i = 0; i < 4; ++i) R.ab[i] = *(const u32x4*)(ato_b + (size_t)i * 32 * 512 + (ko - 512));
      }
    }
#pragma unroll
    for (int i = 0; i < 4; ++i) R.bb[i] = *(const u32x4*)(brow + (size_t)i * 32 * 1024 + ko);
  };
  auto lstore = [&](const Regs& R, int st, int kt) {
    bf16_t* sA = sAB + st * (2 * 128 * 72);
    bf16_t* sB = sA + 128 * 72;
    if (AMODE == 0) {
#pragma unroll
      for (int i = 0; i < 8; ++i) {
        ssq[i] += R.af[i].x * R.af[i].x + R.af[i].y * R.af[i].y + R.af[i].z * R.af[i].z + R.af[i].w * R.af[i].w;
        u32x2 w; w[0] = pack2(R.af[i].x, R.af[i].y); w[1] = pack2(R.af[i].z, R.af[i].w);
        *(u32x2*)(sA + (ar + 16 * i) * 72 + ac) = w;
      }
    } else if (AMODE == 2 && kt < 8) {
      const int kk = tid & 63, tq = tid >> 6;
#pragma unroll
      for (int i = 0; i < 4; ++i)
#pragma unroll
        for (int q = 0; q < 4; ++q) {
          sA[(8 * (tq + 4 * i) + 2 * q) * 72 + kk] = (bf16_t)(R.ab[i][q] & 0xffffu);
          sA[(8 * (tq + 4 * i) + 2 * q + 1) * 72 + kk] = (bf16_t)(R.ab[i][q] >> 16);
        }
    } else {
#pragma unroll
      for (int i = 0; i < 4; ++i) {
        if (AMODE == 1 && EPI != 2) { ssq[i] = dot2sq(R.ab[i][0], ssq[i]); ssq[i] = dot2sq(R.ab[i][1], ssq[i]); ssq[i] = dot2sq(R.ab[i][2], ssq[i]); ssq[i] = dot2sq(R.ab[i][3], ssq[i]); }
        *(u32x4*)(sA + (br + 32 * i) * 72 + bc) = R.ab[i];
      }
    }
#pragma unroll
    for (int i = 0; i < 4; ++i) *(u32x4*)(sB + (br + 32 * i) * 72 + bc) = R.bb[i];
  };
  auto compute = [&](int st) {
    const bf16_t* sA = sAB + st * (2 * 128 * 72);
    const bf16_t* sB = sA + 128 * 72;
#pragma unroll
    for (int ks = 0; ks < 4; ++ks) {
      bf16x8 a[2], b[2];
#pragma unroll
      for (int mi = 0; mi < 2; ++mi) a[mi] = *(const bf16x8*)(sA + (wm * 64 + mi * 32 + lr) * 72 + ks * 16 + lh * 8);
#pragma unroll
      for (int ni = 0; ni < 2; ++ni) b[ni] = *(const bf16x8*)(sB + (wn * 64 + ni * 32 + lr) * 72 + ks * 16 + lh * 8);
#pragma unroll
      for (int mi = 0; mi < 2; ++mi)
#pragma unroll
        for (int ni = 0; ni < 2; ++ni) acc[mi][ni] = MFMA32(a[mi], b[ni], acc[mi][ni]);
    }
  };
  __syncthreads();
  if (AMODE == 0) {
    gload(R0, 0);
    lstore(R0, 0, 0);
    gload(R0, 1);
    __syncthreads();
#pragma unroll 1
    for (int kt = 0; kt < 16; ++kt) {
      compute(kt & 1);
      if (kt + 1 < 16) lstore(R0, (kt + 1) & 1, kt + 1);
      gload(R0, kt + 2);
      __syncthreads();
    }
  } else {
    gload(R0, 0);
    gload(R1, 1);
    lstore(R0, 0, 0);
    gload(R0, 2);
    __syncthreads();
#pragma unroll 1
    for (int kt = 0; kt < 16; kt += 2) {
      compute(0);
      lstore(R1, 1, kt + 1);
      gload(R1, kt + 3);
      __syncthreads();
      compute(1);
      if (kt + 2 < 16) lstore(R0, 0, kt + 2);
      gload(R0, kt + 4);
      __syncthreads();
    }
  }
  if (AMODE == 0) {
#pragma unroll
    for (int i = 0; i < 8; ++i) {
      float v = ssq[i];
      v += __shfl_xor(v, 1); v += __shfl_xor(v, 2); v += __shfl_xor(v, 4); v += __shfl_xor(v, 8);
      if ((tid & 15) == 0) sR[ar + 16 * i] = rsqrtf(v * (1.f / 1024.f) + 1e-6f);
    }
    __syncthreads();
  } else if (AMODE == 1 && EPI != 2) {
#pragma unroll
    for (int i = 0; i < 4; ++i) {
      float v = ssq[i];
      v += __shfl_xor(v, 1); v += __shfl_xor(v, 2); v += __shfl_xor(v, 4);
      if ((tid & 7) == 0) sR[br + 32 * i] = rsqrtf(v * (1.f / 1024.f) + 1e-6f);
    }
    __syncthreads();
  }
  const int rowbase = mt * 128;
  if (EPI == 2) {
#pragma unroll
    for (int mi = 0; mi < 2; ++mi)
#pragma unroll
      for (int ni = 0; ni < 2; ++ni) {
        const int col = nt * 128 + wn * 64 + ni * 32 + lr;
#pragma unroll
        for (int gi = 0; gi < 4; ++gi) {
          const int row4 = wm * 64 + mi * 32 + 8 * gi + 4 * lh;
          const int tok = tok0 + rowbase + row4;
#pragma unroll
          for (int k = 0; k < 4; ++k) {
            const int tk = tok + k;
            const float* xr = (tk < 16384 ? xcp + (size_t)tk * 1024 : xcs + (size_t)(tk - 16384) * 1024);
            const float xn = xr[col] + acc[mi][ni][4 * gi + k];
            p.out[(size_t)tk * 1024 + col] = xn;
            ((bf16_t*)(p.R + (AMODE == 2 ? XB_OFF : XBE_OFF)))[(size_t)tk * 1024 + col] = f2bf(xn);
          }
        }
      }
    return;
  }
  bool colmajor; int ropehalf = 0; float scl = 1.f; int kind = 0; bf16_t* fbase = nullptr;
  bf16_t* dst; size_t dld;
  int sh = 0;
  if (EPI == 0) {
    const int tb = tok0 + rowbase;
    if (nt < 12) { colmajor = true; dst = (bf16_t*)(p.R + U_OFF) + (size_t)(nt * 128) * NT + tb; dld = NT; }
    else if (nt < 16) { colmajor = true; dst = (bf16_t*)(p.R + HG_OFF) + (size_t)((nt - 12) * 128) * NT + tb; dld = NT; }
    else if (nt < 20) { colmajor = false; ropehalf = 8; scl = 0.125f * LOG2E; dst = (bf16_t*)(p.R + Q_OFF) + (size_t)tb * 512 + (nt - 16) * 128; dld = 512; }
    else if (nt == 20) { colmajor = false; ropehalf = 8; kind = 1; fbase = (bf16_t*)(p.R + K_OFF); dst = nullptr; dld = 0; }
    else if (nt == 21) { colmajor = true; kind = 2; fbase = (bf16_t*)(p.R + VT_OFF); dst = nullptr; dld = 0; }
    else { colmajor = false; dst = (bf16_t*)(p.R + AG_OFF) + (size_t)tb * 512 + (nt - 22) * 128; dld = 512; }
  } else {
    if (nt >= 72) { colmajor = false; dst = (bf16_t*)(p.R + GO_OFF) + ((size_t)((tok0 >> 14) & 1) * CH + rowbase) * 1024 + (nt - 72) * 128; dld = 1024; }
    else {
      const int g = nt / 24, which = (nt % 24) / 8, head = nt & 7;
      if (which < 2) {
        colmajor = false; ropehalf = 16; scl = which == 0 ? (0.08838834764831845f * LOG2E) : 1.f;
        dst = (bf16_t*)(p.R + QO_OFF) + ((size_t)g * CH + rowbase) * 1024 + head * 128; dld = 1024;
        sh = g == 0 ? 0 : (g == 1 ? 2 : 4);
        if (which == 1) { kind = 1; fbase = (bf16_t*)(p.R + KO_OFF) + ((size_t)g * 8 + head) * CH * 128; }
      } else {
        colmajor = true; sh = g == 0 ? 0 : (g == 1 ? 2 : 4);
        kind = 2; fbase = (bf16_t*)(p.R + VTO_OFF) + ((size_t)g * 8 + head) * CH * 128; dst = nullptr; dld = 0;
      }
    }
  }
  bf16_t* sC = (bf16_t*)smem;
  const int pos_base = tok0 + rowbase - seq_start_of(tok0 + rowbase);
#pragma unroll
  for (int mi = 0; mi < 2; ++mi)
#pragma unroll
    for (int ni = 0; ni < 2; ++ni) {
      const int cl = wn * 64 + ni * 32 + lr;
#pragma unroll
      for (int gi = 0; gi < 4; ++gi) {
        const int row4 = wm * 64 + mi * 32 + 8 * gi + 4 * lh;
        float v[4];
#pragma unroll
        for (int k = 0; k < 4; ++k) v[k] = acc[mi][ni][4 * gi + k] * sR[row4 + k];
        if (ropehalf == 8) { if (ni == 0) rope4<8>(v, lr, pos_base + row4); }
        else if (ropehalf == 16) { if (wn == 0 && ni == 0) rope4<16>(v, lr, pos_base + row4); }
        if (colmajor) {
          u32x2 w; w[0] = pack2(v[0], v[1]); w[1] = pack2(v[2], v[3]);
          *(u32x2*)(sC + cl * 136 + row4) = w;
        } else {
          const unsigned w0 = pack2(v[0] * scl, v[1] * scl), w1 = pack2(v[2] * scl, v[3] * scl);
          sC[(row4 + 0) * 136 + cl] = (bf16_t)(w0 & 0xffffu); sC[(row4 + 1) * 136 + cl] = (bf16_t)(w0 >> 16);
          sC[(row4 + 2) * 136 + cl] = (bf16_t)(w1 & 0xffffu); sC[(row4 + 3) * 136 + cl] = (bf16_t)(w1 >> 16);
        }
      }
    }
  __syncthreads();
  const int Lq = (EPI == 0) ? 0 : (tok0 == 0 ? 16384 : 4096);
  const int Ls = Lq >> sh;
  const int seqoff = (EPI == 0) ? 0 : (rowbase & ~(Lq - 1));
  const int dmask = (1 << sh) - 1;
  if (kind == 0) {
#pragma unroll
    for (int i = 0; i < 8; ++i) {
      const int chunk = tid + 256 * i;
      const int a_ = chunk >> 4, c8 = (chunk & 15) * 8;
      const u32x4 w = *(const u32x4*)(sC + a_ * 136 + c8);
      *(u32x4*)(dst + (size_t)a_ * dld + c8) = w;
    }
  } else if (kind == 1) {
#pragma unroll
    for (int i = 0; i < 8; ++i) {
      const int chunk = tid + 256 * i;
      const int a_ = chunk >> 4, c8 = (chunk & 15) * 8;
      const u32x4 w = *(const u32x4*)(sC + a_ * 136 + c8);
      int vt, hsel, d8, KS;
      if (EPI == 0) { vt = tok0 + rowbase + a_; hsel = c8 >> 6; d8 = c8 & 63; KS = 4; }
      else { const int n = rowbase + a_ - seqoff; vt = seqoff + (n & dmask) * Ls + (n >> sh); hsel = 0; d8 = c8; KS = 8; }
      const int kk = vt & 31;
      const int rho = ((kk >> 3) & 1) * 16 + ((kk >> 2) & 1) * 8 + (kk >> 4) * 4 + (kk & 3);
      bf16_t* dk = fbase + (size_t)hsel * NT * 64 + ((size_t)((vt >> 5) * KS + (d8 >> 4)) * 64 + ((d8 >> 3) & 1) * 32 + rho) * 8;
      *(u32x4*)dk = w;
    }
  } else {
    const int nb_s = (rowbase - seqoff) >> sh;
    const int d = 1 << sh;
#pragma unroll
    for (int i = 0; i < 8; ++i) {
      const int chunk = tid + 256 * i;
      const int a_ = chunk >> 4, c16 = chunk & 15;
      u32x4 w; int v8;
      if (sh == 0) {
        w = *(const u32x4*)(sC + a_ * 136 + c16 * 8);
        v8 = (EPI == 0 ? tok0 : 0) + rowbase + c16 * 8;
      } else {
        const int r = sh == 2 ? (c16 >> 2) : c16;
        const int sg = sh == 2 ? (c16 & 3) : 0;
        const bf16_t* sp = sC + a_ * 136 + sg * 8 * d + r;
#pragma unroll
        for (int q = 0; q < 4; ++q) w[q] = (unsigned)sp[(2 * q) * d] | ((unsigned)sp[(2 * q + 1) * d] << 16);
        v8 = seqoff + r * Ls + nb_s + sg * 8;
      }
      const int hsel = EPI == 0 ? (a_ >> 6) : 0;
      const int dim = EPI == 0 ? (a_ & 63) : a_;
      const int DT = EPI == 0 ? 2 : 4;
      const int within = v8 & 31;
      bf16_t* dv = fbase + (size_t)hsel * NT * 64 + ((((size_t)(v8 >> 5) * DT + (dim >> 5)) * 2 + ((within >> 3) & 1)) * 64 + (within >> 4) * 32 + (dim & 31)) * 8;
      *(u32x4*)dv = w;
    }
  }
}

template <int AMODE, int EPI>
DI void gemm_run(const Params& p, int jfirst, int njobs, int jstride, int ntn, int tok0, const float* xcp, const float* xcs,
                 const bf16_t* Ab, const bf16_t* Wt, char* smem) {
  if (jfirst >= njobs) return;
  bf16_t* sAB = (bf16_t*)smem;
  float* sR = (float*)(smem + 2 * 2 * 128 * 72 * 2);
  const int tid = otid(), lane = tid & 63, wave = __builtin_amdgcn_readfirstlane(tid >> 6);
  const int wm = wave >> 1, wn = wave & 1;
  const int lr = lane & 31, lh = lane >> 5;
  const int ar = tid >> 4, ac = (tid & 15) * 4;
  const int br = tid >> 3, bc = (tid & 7) * 8;
  struct Ptrs { const char* a; const char* a2; const char* b; };
  const unsigned voffF = (unsigned)(ar * 1024 + ac) * 4u;
  const unsigned voffB = (unsigned)(br * 1024 + bc) * 2u;
  const unsigned voffH = ((unsigned)(tid >> 4) * (unsigned)NT + 8u * (unsigned)(tid & 15)) * 2u;
  const unsigned voffT = (unsigned)(br * 512 + bc) * 2u;
  auto setup = [&](int j, Ptrs& P) {
    const int mt = j / ntn, nt = j - mt * ntn;
    const int tokA = tok0 + mt * 128;
    P.a2 = nullptr;
    if (AMODE == 0) {
      P.a = (const char*)(tokA < 16384 ? xcp + (size_t)tokA * 1024 : xcs + (size_t)(tokA - 16384) * 1024);
    } else if (AMODE == 1) {
      P.a = (const char*)((EPI == 1 ? (const bf16_t*)(p.R + XB_OFF) + (size_t)tok0 * 1024 : (EPI == 0 ? (const bf16_t*)(p.R + XBE_OFF) + (size_t)tok0 * 1024 : Ab)) + (size_t)(mt * 128) * 1024);
    } else {
      P.a = (const char*)((const bf16_t*)(p.R + MIX_OFF) + tokA);
      P.a2 = (const char*)((const bf16_t*)(p.R + ATO_OFF) + (size_t)tokA * 512);
    }
    P.b = (const char*)(Wt + (size_t)(nt * 128) * 1024);
  };
  struct Regs { float4 af[AMODE == 0 ? 8 : 1]; u32x4 ab[AMODE == 0 ? 1 : 4]; u32x4 bb[4]; };
  Regs R0, R1;
  float ssq[8];
#pragma unroll
  for (int i = 0; i < 8; ++i) ssq[i] = 0.f;
  Ptrs Pc, Pn;
  bool hasn = false;
  auto gload = [&](Regs& R, int kv) {
    const bool nx = kv >= 16 && hasn;
    const int kt = kv >= 16 ? (hasn ? kv - 16 : 15) : kv;
    const char* pa = nx ? Pn.a : Pc.a;
    const char* pa2 = nx ? Pn.a2 : Pc.a2;
    const char* pb = nx ? Pn.b : Pc.b;
    const int ko = kt * 64;
    if (AMODE == 0) {
      const char* q = pa + (size_t)ko * 4;
#pragma unroll
      for (int i = 0; i < 8; ++i) R.af[i] = *(const float4*)(q + (size_t)i * 16 * 4096 + voffF);
    } else if (AMODE == 1) {
      const char* q = pa + (size_t)ko * 2;
#pragma unroll
      for (int i = 0; i < 4; ++i) R.ab[i] = *(const u32x4*)(q + (size_t)i * 32 * 2048 + voffB);
    } else {
      if (kt < 8) {
        const char* q = pa + (size_t)ko * NT * 2;
#pragma unroll
        for (int i = 0; i < 4; ++i) R.ab[i] = *(const u32x4*)(q + (size_t)i * 16 * NT * 2 + voffH);
      } else {
        const char* q = pa2 + (size_t)(ko - 512) * 2;
#pragma unroll
        for (int i = 0; i < 4; ++i) R.ab[i] = *(const u32x4*)(q + (size_t)i * 32 * 1024 + voffT);
      }
    }
    const char* qb = pb + (size_t)ko * 2;
#pragma unroll
    for (int i = 0; i < 4; ++i) R.bb[i] = *(const u32x4*)(qb + (size_t)i * 32 * 2048 + voffB);
  };
  auto lstore = [&](const Regs& R, int st, int kv) {
    const int kt = kv & 15;
    bf16_t* sA = sAB + st * (2 * 128 * 72);
    bf16_t* sB = sA + 128 * 72;
    if (AMODE == 0) {
#pragma unroll
      for (int i = 0; i < 8; ++i) {
        ssq[i] += R.af[i].x * R.af[i].x + R.af[i].y * R.af[i].y + R.af[i].z * R.af[i].z + R.af[i].w * R.af[i].w;
        u32x2 w; w[0] = pack2(R.af[i].x, R.af[i].y); w[1] = pack2(R.af[i].z, R.af[i].w);
        *(u32x2*)(sA + (ar + 16 * i) * 72 + ac) = w;
      }
    } else if (AMODE == 2 && kt < 8) {
#pragma unroll
      for (int i = 0; i < 4; ++i) *(u32x4*)((char*)sA + ((tid >> 4) + 16 * i) * 272 + (tid & 15) * 16) = R.ab[i];
    } else {
#pragma unroll
      for (int i = 0; i < 4; ++i) {
        if (AMODE == 1 && EPI != 2) { ssq[i] = dot2sq(R.ab[i][0], ssq[i]); ssq[i] = dot2sq(R.ab[i][1], ssq[i]); ssq[i] = dot2sq(R.ab[i][2], ssq[i]); ssq[i] = dot2sq(R.ab[i][3], ssq[i]); }
        *(u32x4*)(sA + (br + 32 * i) * 72 + bc) = R.ab[i];
      }
    }
#pragma unroll
    for (int i = 0; i < 4; ++i) *(u32x4*)(sB + (br + 32 * i) * 72 + bc) = R.bb[i];
  };
  const int l15 = lane & 15, kg = lane >> 4;
  f32x4 acc[4][4];
  typedef __attribute__((ext_vector_type(4))) short s16x4_t;
  auto compute = [&](int st, int ktile) {
    const bf16_t* sA = sAB + st * (2 * 128 * 72);
    const bf16_t* sB = sA + 128 * 72;
    const bool trA = (AMODE == 2) && (ktile < 8);
#pragma unroll
    for (int ks = 0; ks < 2; ++ks) {
      bf16x8 a[4], b[4];
      if (trA) {
        const char* tb = (const char*)sA + 272 * (32 * ks + 8 * kg + ((lane & 15) >> 2)) + 8 * (lane & 3);
#pragma unroll
        for (int mi = 0; mi < 4; ++mi) {
          const int c = 4 * wm + mi;
          const s16x4_t lo = __builtin_amdgcn_ds_read_tr16_b64_v4i16((__attribute__((address_space(3))) s16x4_t*)(tb + 32 * c));
          const s16x4_t hi = __builtin_amdgcn_ds_read_tr16_b64_v4i16((__attribute__((address_space(3))) s16x4_t*)(tb + 32 * c + 272 * 4));
          a[mi] = __builtin_shufflevector(lo, hi, 0, 1, 2, 3, 4, 5, 6, 7);
        }
      } else {
#pragma unroll
        for (int mi = 0; mi < 4; ++mi) a[mi] = *(const bf16x8*)(sA + (wm * 64 + mi * 16 + l15) * 72 + ks * 32 + kg * 8);
      }
#pragma unroll
      for (int ni = 0; ni < 4; ++ni) b[ni] = *(const bf16x8*)(sB + (wn * 64 + ni * 16 + l15) * 72 + ks * 32 + kg * 8);
#pragma unroll
      for (int mi = 0; mi < 4; ++mi)
#pragma unroll
        for (int ni = 0; ni < 4; ++ni) acc[mi][ni] = __builtin_amdgcn_mfma_f32_16x16x32_bf16(a[mi], b[ni], acc[mi][ni], 0, 0, 0);
    }
  };
  auto finish_rstd = [&]() {
    if (AMODE == 0) {
#pragma unroll
      for (int i = 0; i < 8; ++i) {
        float v = ssq[i];
        v += __shfl_xor(v, 1); v += __shfl_xor(v, 2); v += __shfl_xor(v, 4); v += __shfl_xor(v, 8);
        if ((tid & 15) == 0) sR[ar + 16 * i] = rsqrtf(v * (1.f / 1024.f) + 1e-6f);
        ssq[i] = 0.f;
      }
    } else if (AMODE == 1 && EPI != 2) {
#pragma unroll
      for (int i = 0; i < 4; ++i) {
        float v = ssq[i];
        v += dpp_f(v, 0); v += dpp_f(v, 1); v += dpp_f(v, 2);
        if ((tid & 7) == 0) sR[br + 32 * i] = rsqrtf(v * (1.f / 1024.f) + 1e-6f);
        ssq[i] = 0.f;
      }
    }
  };
  int jcur = jfirst;
  setup(jcur, Pc);
  __syncthreads();
  gload(R0, 0);
  if (AMODE != 0) gload(R1, 1);
  lstore(R0, 0, 0);
  gload(R0, AMODE == 0 ? 1 : 2);
  __syncthreads();
#pragma unroll 1
  for (;;) {
    const int jn = jcur + jstride;
    hasn = jn < njobs;
    if (hasn) setup(jn, Pn);
    const int mt = jcur / ntn, nt = jcur - mt * ntn;
    float zf = 0.f;
    asm volatile("" : "+v"(zf));
#pragma unroll
    for (int a_ = 0; a_ < 4; ++a_)
#pragma unroll
      for (int b_ = 0; b_ < 4; ++b_)
#pragma unroll
        for (int i = 0; i < 4; ++i) acc[a_][b_][i] = zf;
    __builtin_amdgcn_s_setprio(2);
    if (AMODE == 0) {
#pragma unroll 1
      for (int kt = 0; kt < 16; ++kt) {
        compute(kt & 1, kt);
        if (kt == 15) finish_rstd();
        lstore(R0, (kt + 1) & 1, kt + 1);
        gload(R0, kt + 2);
        __syncthreads();
      }
    } else {
#pragma unroll 1
      for (int kt = 0; kt < 16; kt += 2) {
        compute(0, kt);
        lstore(R1, 1, kt + 1);
        gload(R1, kt + 3);
        __syncthreads();
        compute(1, kt + 1);
        if (kt == 14) finish_rstd();
        lstore(R0, 0, kt + 2);
        gload(R0, kt + 4);
        __syncthreads();
      }
    }
    __builtin_amdgcn_s_setprio(0);
  const int rowbase = mt * 128;
  if (EPI == 2) {
    const float* xbase = (tok0 + rowbase) < 16384 ? xcp : xcs - (size_t)16384 * 1024;
#pragma unroll
    for (int mi = 0; mi < 4; ++mi) {
#pragma unroll
      for (int ni = 0; ni < 4; ++ni) {
        const int col = nt * 128 + wn * 64 + ni * 16 + l15;
        const int tok = tok0 + rowbase + wm * 64 + mi * 16 + 4 * kg;
#pragma unroll
        for (int k = 0; k < 4; ++k) {
          const unsigned off = (unsigned)(tok + k) * 1024u + (unsigned)col;
          const float xn = xbase[off] + acc[mi][ni][k];
          p.out[off] = xn;
          ((bf16_t*)(p.R + (AMODE == 2 ? XB_OFF : XBE_OFF)))[off] = f2bf(xn);
        }
      }
      __builtin_amdgcn_sched_barrier(0);
    }
  } else {
  bool colmajor; int ropehalf = 0; float scl = 1.f; int kind = 0; bf16_t* fbase = nullptr;
  bf16_t* dst; size_t dld;
  int sh = 0;
  if (EPI == 0) {
    const int tb = tok0 + rowbase;
    if (nt < 12) { colmajor = true; dst = (bf16_t*)(p.R + U_OFF) + (size_t)(nt * 128) * NT + tb; dld = NT; }
    else if (nt < 16) { colmajor = true; dst = (bf16_t*)(p.R + HG_OFF) + (size_t)((nt - 12) * 128) * NT + tb; dld = NT; }
    else if (nt < 20) { colmajor = false; ropehalf = 8; scl = 0.125f * LOG2E; dst = (bf16_t*)(p.R + Q_OFF) + (size_t)tb * 512 + (nt - 16) * 128; dld = 512; }
    else if (nt == 20) { colmajor = false; ropehalf = 8; kind = 1; fbase = (bf16_t*)(p.R + K_OFF); dst = nullptr; dld = 0; }
    else if (nt == 21) { colmajor = true; kind = 2; fbase = (bf16_t*)(p.R + VT_OFF); dst = nullptr; dld = 0; }
    else { colmajor = false; dst = (bf16_t*)(p.R + AG_OFF) + (size_t)tb * 512 + (nt - 22) * 128; dld = 512; }
  } else {
    if (nt >= 72) { colmajor = false; dst = (bf16_t*)(p.R + GO_OFF) + ((size_t)((tok0 >> 14) & 1) * CH + rowbase) * 1024 + (nt - 72) * 128; dld = 1024; }
    else {
      const int g = nt / 24, which = (nt % 24) / 8, head = nt & 7;
      if (which < 2) {
        colmajor = false; ropehalf = 16; scl = which == 0 ? (0.08838834764831845f * LOG2E) : 1.f;
        dst = (bf16_t*)(p.R + QO_OFF) + ((size_t)g * CH + rowbase) * 1024 + head * 128; dld = 1024;
        sh = g == 0 ? 0 : (g == 1 ? 2 : 4);
        if (which == 1) { kind = 1; fbase = (bf16_t*)(p.R + KO_OFF) + ((size_t)g * 8 + head) * CH * 128; }
      } else {
        colmajor = true; sh = g == 0 ? 0 : (g == 1 ? 2 : 4);
        kind = 2; fbase = (bf16_t*)(p.R + VTO_OFF) + ((size_t)g * 8 + head) * CH * 128; dst = nullptr; dld = 0;
      }
    }
  }
  bf16_t* sC = (bf16_t*)(smem + 2 * 128 * 72 * 2);
  const int pos_base = tok0 + rowbase - seq_start_of(tok0 + rowbase);
#pragma unroll
  for (int mi = 0; mi < 4; ++mi) {
    const int row4 = wm * 64 + mi * 16 + 4 * kg;
    float rs[4];
#pragma unroll
    for (int k = 0; k < 4; ++k) rs[k] = sR[row4 + k];
    float v[4][4];
#pragma unroll
    for (int ni = 0; ni < 4; ++ni)
#pragma unroll
      for (int k = 0; k < 4; ++k) v[ni][k] = acc[mi][ni][k] * rs[k];
    if (ropehalf == 8) {
      rope4<8>(v[0], l15, pos_base + row4);
    } else if (ropehalf == 16) {
      if (wn == 0) {
        const float inv = exp2f(-((float)l15 / 16.f) * 18.931568569324174f);
#pragma unroll
        for (int k = 0; k < 4; ++k) {
          const float ang = (float)(pos_base + row4 + k) * inv;
          const float n = __builtin_rintf(ang * 0.15915494309189535f);
          float r = __builtin_fmaf(-n, 6.28318548202514648f, ang);
          r = __builtin_fmaf(-n, -1.7484555e-7f, r);
          const float fr = r * 0.15915494309189535f;
          const float sn = __builtin_amdgcn_sinf(fr), cs = __builtin_amdgcn_cosf(fr);
          const float x1 = v[0][k], x2 = v[1][k];
          v[0][k] = x1 * cs - x2 * sn;
          v[1][k] = x2 * cs + x1 * sn;
        }
      }
    }
#pragma unroll
    for (int ni = 0; ni < 4; ++ni) {
      const int cl = wn * 64 + ni * 16 + l15;
      if (colmajor) {
        u32x2 w; w[0] = pack2(v[ni][0], v[ni][1]); w[1] = pack2(v[ni][2], v[ni][3]);
        *(u32x2*)(sC + cl * 136 + row4) = w;
      } else {
        const unsigned w0 = pack2(v[ni][0] * scl, v[ni][1] * scl), w1 = pack2(v[ni][2] * scl, v[ni][3] * scl);
        sC[(row4 + 0) * 136 + cl] = (bf16_t)(w0 & 0xffffu); sC[(row4 + 1) * 136 + cl] = (bf16_t)(w0 >> 16);
        sC[(row4 + 2) * 136 + cl] = (bf16_t)(w1 & 0xffffu); sC[(row4 + 3) * 136 + cl] = (bf16_t)(w1 >> 16);
      }
    }
    asm volatile("" ::: "memory");
  }
  __syncthreads();
  const int Lq = (EPI == 0) ? 0 : (tok0 == 0 ? 16384 : 4096);
  const int Ls = Lq >> sh;
  const int seqoff = (EPI == 0) ? 0 : (rowbase & ~(Lq - 1));
  const int dmask = (1 << sh) - 1;
  if (kind == 0) {
#pragma unroll 4
    for (int i = 0; i < 8; ++i) {
      const int chunk = tid + 256 * i;
      const int a_ = chunk >> 4, c8 = (chunk & 15) * 8;
      const u32x4 w = *(const u32x4*)(sC + a_ * 136 + c8);
      *(u32x4*)(dst + (size_t)a_ * dld + c8) = w;
    }
  } else if (kind == 1 && sh != 4) {
    const int KS = EPI == 0 ? 4 : 8;
#pragma unroll 4
    for (int i = 0; i < 8; ++i) {
      const int chunk = tid + 256 * i;
      const int rho = chunk & 31, lhd = (chunk >> 5) & 1, ksx = (chunk >> 6) & 7, blk = chunk >> 9;
      const int kap = ((rho >> 2) & 1) * 16 + (rho >> 4) * 8 + ((rho >> 3) & 1) * 4 + (rho & 3);
      const int a_ = sh == 0 ? 32 * blk + kap : 4 * kap + blk;
      const u32x4 w = *(const u32x4*)(sC + a_ * 136 + (ksx * 2 + lhd) * 8);
      const int hsel = EPI == 0 ? (ksx >> 2) : 0;
      const int ks = EPI == 0 ? (ksx & 3) : ksx;
      const int blockid = sh == 0 ? (((EPI == 0 ? tok0 : 0) + rowbase) >> 5) + blk
                                  : (seqoff + blk * Ls + ((rowbase - seqoff) >> sh)) >> 5;
      bf16_t* dk = fbase + (size_t)hsel * NT * 64 + ((size_t)(blockid * KS + ks) * 64 + lhd * 32 + rho) * 8;
      *(u32x4*)dk = w;
    }
  } else if (kind == 1) {
#pragma unroll 4
    for (int i = 0; i < 8; ++i) {
      const int chunk = tid + 256 * i;
      const int a_ = chunk >> 4, c8 = (chunk & 15) * 8;
      const u32x4 w = *(const u32x4*)(sC + a_ * 136 + c8);
      int vt, hsel, d8, KS;
      if (EPI == 0) { vt = tok0 + rowbase + a_; hsel = c8 >> 6; d8 = c8 & 63; KS = 4; }
      else { const int n = rowbase + a_ - seqoff; vt = seqoff + (n & dmask) * Ls + (n >> sh); hsel = 0; d8 = c8; KS = 8; }
      const int kk = vt & 31;
      const int rho = ((kk >> 3) & 1) * 16 + ((kk >> 2) & 1) * 8 + (kk >> 4) * 4 + (kk & 3);
      bf16_t* dk = fbase + (size_t)hsel * NT * 64 + ((size_t)((vt >> 5) * KS + (d8 >> 4)) * 64 + ((d8 >> 3) & 1) * 32 + rho) * 8;
      *(u32x4*)dk = w;
    }
  } else if (sh != 4) {
    const int DT = EPI == 0 ? 2 : 4;
#pragma unroll 4
    for (int i = 0; i < 8; ++i) {
      const int chunk = tid + 256 * i;
      const int d31 = chunk & 31, lhv = (chunk >> 5) & 1, sv = (chunk >> 6) & 1, dtx = (chunk >> 7) & 3, blk = chunk >> 9;
      const int a_ = dtx * 32 + d31;
      const int within = 16 * lhv + 8 * sv;
      u32x4 w; int blockid;
      if (sh == 0) {
        w = *(const u32x4*)(sC + a_ * 136 + 32 * blk + within);
        blockid = (((EPI == 0 ? tok0 : 0) + rowbase) >> 5) + blk;
      } else {
        const bf16_t* sp = sC + a_ * 136 + within * 4 + blk;
#pragma unroll
        for (int q = 0; q < 4; ++q) w[q] = (unsigned)sp[(2 * q) * 4] | ((unsigned)sp[(2 * q + 1) * 4] << 16);
        blockid = (seqoff + blk * Ls + ((rowbase - seqoff) >> sh)) >> 5;
      }
      const int hsel = EPI == 0 ? (dtx >> 1) : 0;
      const int dt = EPI == 0 ? (dtx & 1) : dtx;
      bf16_t* dv = fbase + (size_t)hsel * NT * 64 + ((((size_t)blockid * DT + dt) * 2 + sv) * 64 + lhv * 32 + d31) * 8;
      *(u32x4*)dv = w;
    }
  } else {
    const int nb_s = (rowbase - seqoff) >> sh;
    const int d = 1 << sh;
#pragma unroll 4
    for (int i = 0; i < 8; ++i) {
      const int chunk = tid + 256 * i;
      const int a_ = chunk >> 4, c16 = chunk & 15;
      u32x4 w; int v8;
      if (sh == 0) {
        w = *(const u32x4*)(sC + a_ * 136 + c16 * 8);
        v8 = (EPI == 0 ? tok0 : 0) + rowbase + c16 * 8;
      } else {
        const int r = sh == 2 ? (c16 >> 2) : c16;
        const int sg = sh == 2 ? (c16 & 3) : 0;
        const bf16_t* sp = sC + a_ * 136 + sg * 8 * d + r;
#pragma unroll
        for (int q = 0; q < 4; ++q) w[q] = (unsigned)sp[(2 * q) * d] | ((unsigned)sp[(2 * q + 1) * d] << 16);
        v8 = seqoff + r * Ls + nb_s + sg * 8;
      }
      const int hsel = EPI == 0 ? (a_ >> 6) : 0;
      const int dim = EPI == 0 ? (a_ & 63) : a_;
      const int DT = EPI == 0 ? 2 : 4;
      const int within = v8 & 31;
      bf16_t* dv = fbase + (size_t)hsel * NT * 64 + ((((size_t)(v8 >> 5) * DT + (dim >> 5)) * 2 + ((within >> 3) & 1)) * 64 + (within >> 4) * 32 + (dim & 31)) * 8;
      *(u32x4*)dv = w;
    }
  }
  }
    __syncthreads();
    if (!hasn) break;
    jcur = jn; Pc = Pn;
  }
}

template <int HD, bool EVEN>
DI void attn_wave(const bf16_t* __restrict__ Qb, int qs, const bf16_t* __restrict__ KFb,
                  const bf16_t* __restrict__ VFb, int Ls, int dil, int res, int s0, int R,
                  float m_init, float l_init, bf16_t* __restrict__ Ob, int os,
                  const bf16_t* __restrict__ Gb, int gs, float* __restrict__ lse_b) {
  const int lane = otid() & 63, lr = lane & 31, lh = lane >> 5;
  constexpr bool QREG = true;
  bf16x8 qf[QREG ? HD / 16 : 1];
  const bf16_t* qp = Qb + (size_t)((s0 + lr) * dil + res) * qs + lh * 8;
  if (QREG) {
#pragma unroll
    for (int ks = 0; ks < HD / 16; ++ks) qf[ks] = *(const bf16x8*)(qp + ks * 16);
  }
  f32x16 O[HD / 32];
#pragma unroll
  for (int dt = 0; dt < HD / 32; ++dt)
#pragma unroll
    for (int i = 0; i < 16; ++i) O[dt][i] = 0.f;
  float m = m_init;
  float l = (lh == 0) ? l_init : 0.f;
  const int qq = s0 + lr;
  for (int kb = s0 - R; kb <= s0 + R; kb += 32) {
    if (kb + 31 < 0 || kb >= Ls) continue;
    const bf16_t* kp = KFb + ((size_t)(kb >> 5) * (HD / 16) * 64 + lane) * 8;
    bf16x8 vfr[2][HD / 32];
    {
      const bf16_t* vp = VFb + ((size_t)(kb >> 5) * (HD / 32) * 2 * 64 + lane) * 8;
#pragma unroll
      for (int dt = 0; dt < HD / 32; ++dt)
#pragma unroll
        for (int s2 = 0; s2 < 2; ++s2) vfr[s2][dt] = *(const bf16x8*)(vp + (dt * 2 + s2) * 512);
    }
    f32x16 S;
#pragma unroll
    for (int i = 0; i < 16; ++i) S[i] = 0.f;
#pragma unroll
    for (int ks = 0; ks < HD / 16; ++ks) S = MFMA32(*(const bf16x8*)(kp + ks * 512), qf[ks], S);
    float mx = -1e30f;
    unsigned okm = 0;
    const bool interior = (kb >= s0 + 31 - R) && (kb <= s0 + R - 31) && (kb >= 0) && (kb + 32 <= Ls);
    if (interior) {
      okm = 0xFFFFu;
#pragma unroll
      for (int i = 0; i < 16; ++i) mx = fmaxf(mx, S[i]);
    } else {
#pragma unroll
      for (int i = 0; i < 16; ++i) {
        const int kk = kb + 16 * lh + i;
        int df = kk - qq; df = df < 0 ? -df : df;
        const bool ok = (kk >= 0) && (kk < Ls) && (df <= R);
        okm |= ok ? (1u << i) : 0u;
        S[i] = ok ? S[i] : -1e30f;
        mx = fmaxf(mx, S[i]);
      }
    }
    mx = xhalf_max(mx);
    const float mn = fmaxf(m, mx);
    const float alpha = __builtin_amdgcn_exp2f(m - mn);
    m = mn;
    float rs = 0.f;
#pragma unroll
    for (int i = 0; i < 16; ++i) {
      const float pe = ((okm >> i) & 1u) ? __builtin_amdgcn_exp2f(S[i] - mn) : 0.f;
      S[i] = pe; rs += pe;
    }
    l = l * alpha + rs;
#pragma unroll
    for (int dt = 0; dt < HD / 32; ++dt)
#pragma unroll
      for (int i = 0; i < 16; ++i) O[dt][i] *= alpha;
#pragma unroll
    for (int s = 0; s < 2; ++s) {
      u32x4 pw;
#pragma unroll
      for (int q = 0; q < 4; ++q) pw[q] = pack2(S[8 * s + 2 * q], S[8 * s + 2 * q + 1]);
      const bf16x8 pf = __builtin_bit_cast(bf16x8, pw);
#pragma unroll
      for (int dt = 0; dt < HD / 32; ++dt) {
        O[dt] = MFMA32(vfr[s][dt], pf, O[dt]);
      }
    }
  }
  const float lt = l + __shfl_xor(l, 32);
  const float inv = 1.f / lt;
  const size_t row = (size_t)((s0 + lr) * dil + res);
  if (!EVEN) { if (lh == 0) lse_b[row * 8] = m + __log2f(lt); }
#pragma unroll
  for (int dt = 0; dt < HD / 32; ++dt)
#pragma unroll
    for (int gi = 0; gi < 4; ++gi) {
      const int dim4 = dt * 32 + 8 * gi + 4 * lh;
      float v[4];
#pragma unroll
      for (int k = 0; k < 4; ++k) v[k] = O[dt][4 * gi + k] * inv;
      if (EVEN) {
        const u32x2 gw = *(const u32x2*)(Gb + row * gs + dim4);
        v[0] *= silu(bflo(gw[0])); v[1] *= silu(bfhi(gw[0])); v[2] *= silu(bflo(gw[1])); v[3] *= silu(bfhi(gw[1]));
      }
      store4bf(Ob + row * os + dim4, v);
    }
}

template <int HD, bool EVEN>
DI void attn_wave_db(const bf16_t* __restrict__ Qb, int qs, const bf16_t* __restrict__ KFb,
                  const bf16_t* __restrict__ VFb, int Ls, int dil, int res, int s0, int R,
                  float m_init, float l_init, bf16_t* __restrict__ Ob, int os,
                  const bf16_t* __restrict__ Gb, int gs, float* __restrict__ lse_b) {
  const int lane = otid() & 63, lr = lane & 31, lh = lane >> 5;
  constexpr bool QREG = true;
  bf16x8 qf[QREG ? HD / 16 : 1];
  const bf16_t* qp = Qb + (size_t)((s0 + lr) * dil + res) * qs + lh * 8;
  if (QREG) {
#pragma unroll
    for (int ks = 0; ks < HD / 16; ++ks) qf[ks] = *(const bf16x8*)(qp + ks * 16);
  }
  f32x16 O[HD / 32];
#pragma unroll
  for (int dt = 0; dt < HD / 32; ++dt)
#pragma unroll
    for (int i = 0; i < 16; ++i) O[dt][i] = 0.f;
  float m = m_init;
  float l = (lh == 0) ? l_init : 0.f;
  const int qq = s0 + lr;
  constexpr int KS = HD / 16, DT = HD / 32;
  auto kvload = [&](bf16x8 (&kf)[KS], bf16x8 (&vfr)[2][DT], int kb) {
    const bf16_t* kp = KFb + ((size_t)(kb >> 5) * KS * 64 + lane) * 8;
    const bf16_t* vp = VFb + ((size_t)(kb >> 5) * DT * 2 * 64 + lane) * 8;
#pragma unroll
    for (int ks = 0; ks < KS; ++ks) kf[ks] = *(const bf16x8*)(kp + ks * 512);
#pragma unroll
    for (int dt = 0; dt < DT; ++dt)
#pragma unroll
      for (int s2 = 0; s2 < 2; ++s2) vfr[s2][dt] = *(const bf16x8*)(vp + (dt * 2 + s2) * 512);
  };
  auto step = [&](const bf16x8 (&kf)[KS], const bf16x8 (&vfr)[2][DT], int kb) {
    f32x16 S;
#pragma unroll
    for (int i = 0; i < 16; ++i) S[i] = 0.f;
#pragma unroll
    for (int ks = 0; ks < HD / 16; ++ks) S = MFMA32(kf[ks], qf[ks], S);
    float mx = -1e30f;
    unsigned okm = 0;
    const bool interior = (kb >= s0 + 31 - R) && (kb <= s0 + R - 31) && (kb >= 0) && (kb + 32 <= Ls);
    if (interior) {
      okm = 0xFFFFu;
#pragma unroll
      for (int i = 0; i < 16; ++i) mx = fmaxf(mx, S[i]);
    } else {
#pragma unroll
      for (int i = 0; i < 16; ++i) {
        const int kk = kb + 16 * lh + i;
        int df = kk - qq; df = df < 0 ? -df : df;
        const bool ok = (kk >= 0) && (kk < Ls) && (df <= R);
        okm |= ok ? (1u << i) : 0u;
        S[i] = ok ? S[i] : -1e30f;
        mx = fmaxf(mx, S[i]);
      }
    }
    mx = xhalf_max(mx);
    const float mn = fmaxf(m, mx);
    const float alpha = __builtin_amdgcn_exp2f(m - mn);
    m = mn;
    float rs = 0.f;
#pragma unroll
    for (int i = 0; i < 16; ++i) {
      const float pe = ((okm >> i) & 1u) ? __builtin_amdgcn_exp2f(S[i] - mn) : 0.f;
      S[i] = pe; rs += pe;
    }
    l = l * alpha + rs;
#pragma unroll
    for (int dt = 0; dt < HD / 32; ++dt)
#pragma unroll
      for (int i = 0; i < 16; ++i) O[dt][i] *= alpha;
#pragma unroll
    for (int s = 0; s < 2; ++s) {
      u32x4 pw;
#pragma unroll
      for (int q = 0; q < 4; ++q) pw[q] = pack2(S[8 * s + 2 * q], S[8 * s + 2 * q + 1]);
      const bf16x8 pf = __builtin_bit_cast(bf16x8, pw);
#pragma unroll
      for (int dt = 0; dt < HD / 32; ++dt) {
        O[dt] = MFMA32(vfr[s][dt], pf, O[dt]);
      }
    }
  };
  const int kb_lo = s0 - R < 0 ? 0 : s0 - R;
  const int kb_hi = s0 + R > Ls - 32 ? Ls - 32 : s0 + R;
  {
    bf16x8 kA[KS], vA[2][DT], kB[KS], vB[2][DT];
    kvload(kA, vA, kb_lo);
    for (int kb = kb_lo; kb <= kb_hi; kb += 64) {
      kvload(kB, vB, kb + 32 <= kb_hi ? kb + 32 : kb_hi);
      step(kA, vA, kb);
      if (kb + 32 <= kb_hi) {
        kvload(kA, vA, kb + 64 <= kb_hi ? kb + 64 : kb_hi);
        step(kB, vB, kb + 32);
      }
    }
  }
  const float lt = l + __shfl_xor(l, 32);
  const float inv = 1.f / lt;
  const size_t row = (size_t)((s0 + lr) * dil + res);
  if (!EVEN) { if (lh == 0) lse_b[row * 8] = m + __log2f(lt); }
#pragma unroll
  for (int dt = 0; dt < HD / 32; ++dt)
#pragma unroll
    for (int gi = 0; gi < 4; ++gi) {
      const int dim4 = dt * 32 + 8 * gi + 4 * lh;
      float v[4];
#pragma unroll
      for (int k = 0; k < 4; ++k) v[k] = O[dt][4 * gi + k] * inv;
      if (EVEN) {
        const u32x2 gw = *(const u32x2*)(Gb + row * gs + dim4);
        v[0] *= silu(bflo(gw[0])); v[1] *= silu(bfhi(gw[0])); v[2] *= silu(bflo(gw[1])); v[3] *= silu(bfhi(gw[1]));
      }
      store4bf(Ob + row * os + dim4, v);
    }
}

DI void attn_even_job(const Params& p, int li, int bj) {
  const int wave = __builtin_amdgcn_readfirstlane(otid() >> 6);
  const int qt = bj >> 1, kvh = bj & 1;
  const int head = kvh * 4 + wave;
  const int tok0 = qt * 32;
  const int ss = seq_start_of(tok0);
  const int L = tok0 < 16384 ? 16384 : 4096;
  const bf16_t* Q = (const bf16_t*)(p.R + Q_OFF) + (size_t)ss * 512 + head * 64;
  const bf16_t* Kk = (const bf16_t*)(p.R + K_OFF) + ((size_t)kvh * NT + ss) * 64;
  const bf16_t* VT = (const bf16_t*)(p.R + VT_OFF) + ((size_t)kvh * NT + ss) * 64;
  bf16_t* Ob = (bf16_t*)(p.R + ATO_OFF) + (size_t)ss * 512 + head * 64;
  const bf16_t* Gb = (const bf16_t*)(p.R + AG_OFF) + (size_t)ss * 512 + head * 64;
  const float sink2 = p.sink[li * 8 + head] * LOG2E;
  attn_wave_db<64, true>(Q, 512, Kk, VT, L, 1, 0, tok0 - ss, 128, sink2, 1.f, Ob, 512, Gb, 512, nullptr);
}

DI void attn_odd_job(const Params& p, int ch, int bj) {
  const int wave = __builtin_amdgcn_readfirstlane(otid() >> 6);
  const int wj = bj * 4 + wave;
  const int g = wj >> 12, rem = wj & 4095;
  const int head = rem >> 9, tix = rem & 511;
  const int L = ch == 0 ? 16384 : 4096;
  const int sh = g == 0 ? 0 : (g == 1 ? 2 : 4);
  const int Ls = L >> sh;
  const int seqoff = (tix * 32) & ~(L - 1);
  const int w = tix * 32 - seqoff;
  const int r = w / Ls, s0 = w % Ls;
  const bf16_t* Q = (const bf16_t*)(p.R + QO_OFF) + ((size_t)g * CH + seqoff) * 1024 + head * 128;
  const bf16_t* Kk = (const bf16_t*)(p.R + KO_OFF) + (((size_t)g * 8 + head) * CH + seqoff + (size_t)r * Ls) * 128;
  const bf16_t* VT = (const bf16_t*)(p.R + VTO_OFF) + (((size_t)g * 8 + head) * CH + seqoff + (size_t)r * Ls) * 128;
  bf16_t* Ob = (bf16_t*)(p.R + OG_OFF) + ((size_t)g * CH + seqoff) * 1024 + head * 128;
  float* lse = (float*)(p.R + LSE_OFF) + ((size_t)g * CH + seqoff) * 8 + head;
  attn_wave<128, false>(Q, 1024, Kk, VT, Ls, 1 << sh, r, s0, 64, -1e30f, 0.f, Ob, 1024, nullptr, 0, lse);
}

DI void merge_phase(const Params& p, int ch) {
  const bf16_t* Og = (const bf16_t*)(p.R + OG_OFF);
  const float* lse = (const float*)(p.R + LSE_OFF);
  const bf16_t* Go = (const bf16_t*)(p.R + GO_OFF) + (size_t)(ch & 1) * CH * 1024;
  bf16_t* Y = (bf16_t*)(p.R + Y_OFF);
  for (int it = blockIdx.x * 256 + threadIdx.x; it < CH * 128; it += gridDim.x * 256) {
    const int tok = it >> 7, within = it & 127;
    const int head = within >> 4;
    const size_t off = (size_t)tok * 1024 + within * 8;
    float l0 = lse[(size_t)tok * 8 + head], l1 = lse[((size_t)CH + tok) * 8 + head], l2 = lse[((size_t)2 * CH + tok) * 8 + head];
    const float mx = fmaxf(l0, fmaxf(l1, l2));
    float w0 = __builtin_amdgcn_exp2f(l0 - mx), w1 = __builtin_amdgcn_exp2f(l1 - mx), w2 = __builtin_amdgcn_exp2f(l2 - mx);
    const float iv = 1.f / (w0 + w1 + w2);
    w0 *= iv; w1 *= iv; w2 *= iv;
    const u32x4 a = *(const u32x4*)(Og + off);
    const u32x4 b = *(const u32x4*)(Og + (size_t)CH * 1024 + off);
    const u32x4 c = *(const u32x4*)(Og + (size_t)2 * CH * 1024 + off);
    const u32x4 gg = *(const u32x4*)(Go + off);
    u32x4 y;
#pragma unroll
    for (int q = 0; q < 4; ++q) {
      const float lo = (w0 * bflo(a[q]) + w1 * bflo(b[q]) + w2 * bflo(c[q])) * silu(bflo(gg[q]));
      const float hi = (w0 * bfhi(a[q]) + w1 * bfhi(b[q]) + w2 * bfhi(c[q])) * silu(bfhi(gg[q]));
      y[q] = pack2(lo, hi);
    }
    *(u32x4*)(Y + off) = y;
  }
}

struct __attribute__((aligned(4))) U4a { unsigned v[4]; };

DI void sc4(const bf16_t* __restrict__ Uc, int n4, int lmask, float w0, float w1, float w2, float b, float (&o)[4]) {
  const u32x2 w = *(const u32x2*)(Uc + n4);
  const float u0 = bflo(w[0]), u1 = bfhi(w[0]), u2 = bflo(w[1]), u3 = bfhi(w[1]);
  const float um = (n4 & lmask) ? bf2f(Uc[n4 - 1]) : 0.f;
  const float up = ((n4 + 4) & lmask) ? bf2f(Uc[n4 + 4]) : 0.f;
  o[0] = w0 * um + w1 * u0 + w2 * u1 + b;
  o[1] = w0 * u0 + w1 * u1 + w2 * u2 + b;
  o[2] = w0 * u1 + w1 * u2 + w2 * u3 + b;
  o[3] = w0 * u2 + w1 * u3 + w2 * up + b;
}

template <bool SAMPLE>
DI void hyena_job(const Params& p, int li, int c, int grp, char* smem) {
  bf16_t* zl = (bf16_t*)smem;
  const int tid = otid(), lane = tid & 63, wave = __builtin_amdgcn_readfirstlane(tid >> 6), lr = lane & 31, lh = lane >> 5;
  const int tok0 = grp * 16384;
  constexpr int L = SAMPLE ? 4096 : 16384;
  constexpr int nb = L >> 6, lmask = L - 1;
  constexpr int PAD = SAMPLE ? 16 : 32;
  constexpr int SEQB = nb + 2 * PAD + (SAMPLE ? 8 : 0);
  constexpr int LSH = SAMPLE ? 12 : 14;
  const bf16_t* U = (const bf16_t*)(p.R + U_OFF);
  const bf16_t* Uv = U + (size_t)(1024 + c) * NT + tok0;
  const bf16_t* Ux1 = U + (size_t)c * NT + tok0;
  const bf16_t* Ux2 = U + (size_t)(512 + c) * NT + tok0;
  const bf16_t* HGc = (const bf16_t*)(p.R + HG_OFF) + (size_t)c * NT + tok0;
  bf16_t* HYC = (bf16_t*)(p.R + MIX_OFF) + (size_t)c * NT + tok0;
  const float* cw = p.a_conv_w + li * 3 * 1536;
  const float* cb = p.a_conv_b + li * 1536;
  __syncthreads();
  {
    constexpr int NSEQ = SAMPLE ? 4 : 1;
    for (int e = tid; e < NSEQ * 2 * PAD * 8; e += 256) {
      const int q = e / (2 * PAD * 8), r = e - q * (2 * PAD * 8);
      const int pb = r >> 3, part = r & 7;
      const int blk = q * SEQB + (pb < PAD ? pb : nb + pb);
      unsigned zu = 0u;
      asm volatile("" : "+v"(zu));
      u32x4 z; z[0] = zu; z[1] = zu; z[2] = zu; z[3] = zu;
      *(u32x4*)(zl + blk * 72 + part * 8) = z;
    }
    const float w0 = cw[1024 + c], w1 = cw[1536 + 1024 + c], w2 = cw[2 * 1536 + 1024 + c], b = cb[1024 + c];
    for (int n8 = tid; n8 < 2048; n8 += 256) {
      const int n = n8 * 8;
      float o0[4], o1[4];
      sc4(Uv, n, lmask, w0, w1, w2, b, o0);
      sc4(Uv, n + 4, lmask, w0, w1, w2, b, o1);
      u32x4 w; w[0] = pack2(o0[0], o0[1]); w[1] = pack2(o0[2], o0[3]); w[2] = pack2(o1[0], o1[1]); w[3] = pack2(o1[2], o1[3]);
      *(u32x4*)(zl + ((n >> LSH) * SEQB + PAD + ((n & lmask) >> 6)) * 72 + (n & 63)) = w;
    }
  }
  __syncthreads();
  constexpr size_t gstr = SAMPLE ? GSTR_S : GSTR_P;
  constexpr int span = SAMPLE ? 8 : 32;
  constexpr int DSH = span;
  constexpr int CTO = 0;
  constexpr int ctstep = DSH + CTO;
  const int i0w = SAMPLE ? 16 * wave : 64 * wave;
  const int sblk = (SAMPLE ? (lr >> 3) * SEQB : 0) + PAD;
  const int ilane = i0w + (SAMPLE ? (lr & 7) : lr);
  const int dlo = i0w - nb + 1;
  const int dhi = (i0w + DSH + span - 1 < nb - 1) ? i0w + DSH + span - 1 : nb - 1;
  for (int o = 0; o < 2; ++o) {
    const bf16_t* GA = (const bf16_t*)(p.R + (SAMPLE ? GAS_OFF : GAP_OFF)) + (size_t)(o * 512 + c) * gstr;
    const bf16_t* GB = (const bf16_t*)(p.R + (SAMPLE ? GBS_OFF : GBP_OFF)) + (size_t)(o * 512 + c) * gstr;
    const bf16_t* gbase = ((lr & 1) ? GB - 1 : GA) + (L - 32 - lr + 8 * lh);
    f32x16 acc[2][2];
#pragma unroll
    for (int a = 0; a < 2; ++a)
#pragma unroll
      for (int b = 0; b < 2; ++b)
#pragma unroll
        for (int i = 0; i < 16; ++i) acc[a][b][i] = 0.f;
    auto fload = [&](U4a (&P)[6], int d) {
      const int dc = d <= dhi ? d : dhi;
#pragma unroll
      for (int q = 0; q < 6; ++q) P[q] = *(const U4a*)(gbase - 64 * dc + 16 * q);
    };
    auto fcomp = [&](const U4a (&P)[6], int d) {
      if (d > dhi) return;
#pragma unroll
      for (int ct = 0; ct < 2; ++ct) {
        const int i0 = i0w + DSH * ct;
        const int lo_ = i0 - nb + 1, hi_ = (i0 + span - 1 < nb - 1) ? i0 + span - 1 : nb - 1;
        if (d < lo_ || d > hi_) continue;
        const int jb = ilane + DSH * ct - d;
        const bf16_t* zp = zl + (sblk + CTO * ct + jb) * 72 + 8 * lh;
#pragma unroll
        for (int ks = 0; ks < 4; ++ks) {
          const bf16x8 bfr = *(const bf16x8*)(zp + 16 * ks);
#pragma unroll
          for (int rt = 0; rt < 2; ++rt) acc[rt][ct] = MFMA32(__builtin_bit_cast(bf16x8, P[2 - 2 * rt + ks]), bfr, acc[rt][ct]);
        }
      }
    };
    auto fload4 = [&](U4a (&P)[6], int d) {
      const int dc = d <= dhi ? d : dhi;
#pragma unroll
      for (int q = 0; q < 4; ++q) P[q] = *(const U4a*)(gbase - 64 * dc + 16 * q);
    };
    U4a PA[6], PB[6];
    fload(PA, dlo);
    for (int d = dlo; d <= dhi; d += 2) {
      fload4(PB, d + 1);
      fcomp(PA, d);
      PB[4] = PA[0]; PB[5] = PA[1];
      fload4(PA, d + 2);
      fcomp(PB, d + 1);
      PA[4] = PB[0]; PA[5] = PB[1];
    }
    const float dco = p.hyd[li * 1024 + o * 512 + c];
    const int zoff = (sblk + ilane) * 72 + 4 * lh;
#pragma unroll
    for (int rt = 0; rt < 2; ++rt)
#pragma unroll
      for (int ct = 0; ct < 2; ++ct)
#pragma unroll
        for (int gi = 0; gi < 4; ++gi) {
          const u32x2 zw = *(const u32x2*)(zl + zoff + ct * ctstep * 72 + 32 * rt + 8 * gi);
          acc[rt][ct][4 * gi + 0] += dco * bflo(zw[0]); acc[rt][ct][4 * gi + 1] += dco * bfhi(zw[0]);
          acc[rt][ct][4 * gi + 2] += dco * bflo(zw[1]); acc[rt][ct][4 * gi + 3] += dco * bfhi(zw[1]);
        }
    __syncthreads();
#pragma unroll
    for (int rt = 0; rt < 2; ++rt)
#pragma unroll
      for (int ct = 0; ct < 2; ++ct)
#pragma unroll
        for (int gi = 0; gi < 4; ++gi) {
          u32x2 w; w[0] = pack2(acc[rt][ct][4 * gi + 0], acc[rt][ct][4 * gi + 1]); w[1] = pack2(acc[rt][ct][4 * gi + 2], acc[rt][ct][4 * gi + 3]);
          *(u32x2*)(zl + zoff + ct * ctstep * 72 + 32 * rt + 8 * gi) = w;
        }
    __syncthreads();
    {
      const bf16_t* Ug = o == 0 ? Ux1 : Ux2;
      const int gch = o == 0 ? c : 512 + c;
      const float w0 = cw[gch], w1 = cw[1536 + gch], w2 = cw[2 * 1536 + gch], b = cb[gch];
#pragma unroll 1
      for (int n8 = tid; n8 < 2048; n8 += 256) {
        const int n = n8 * 8;
        float g0[4], g1[4];
        sc4(Ug, n, lmask, w0, w1, w2, b, g0);
        sc4(Ug, n + 4, lmask, w0, w1, w2, b, g1);
        bf16_t* zp = zl + ((n >> LSH) * SEQB + PAD + ((n & lmask) >> 6)) * 72 + (n & 63);
        const u32x4 zw = *(const u32x4*)zp;
        float v[8];
        v[0] = g0[0] * bflo(zw[0]); v[1] = g0[1] * bfhi(zw[0]); v[2] = g0[2] * bflo(zw[1]); v[3] = g0[3] * bfhi(zw[1]);
        v[4] = g1[0] * bflo(zw[2]); v[5] = g1[1] * bfhi(zw[2]); v[6] = g1[2] * bflo(zw[3]); v[7] = g1[3] * bfhi(zw[3]);
        if (o == 0) {
          u32x4 w; w[0] = pack2(v[0], v[1]); w[1] = pack2(v[2], v[3]); w[2] = pack2(v[4], v[5]); w[3] = pack2(v[6], v[7]);
          *(u32x4*)zp = w;
        } else {
          const u32x4 gw = *(const u32x4*)(HGc + n);
          u32x4 w;
          w[0] = pack2(v[0] * silu(bflo(gw[0])), v[1] * silu(bfhi(gw[0])));
          w[1] = pack2(v[2] * silu(bflo(gw[1])), v[3] * silu(bfhi(gw[1])));
          w[2] = pack2(v[4] * silu(bflo(gw[2])), v[5] * silu(bfhi(gw[2])));
          w[3] = pack2(v[6] * silu(bflo(gw[3])), v[7] * silu(bfhi(gw[3])));
          *(u32x4*)(HYC + n) = w;
        }
      }
    }
    __syncthreads();
  }
}

DI void final_phase(const Params& p) {
  const int lane = threadIdx.x & 63, wave = __builtin_amdgcn_readfirstlane(threadIdx.x >> 6);
  for (int row = blockIdx.x * 4 + wave; row < NT; row += gridDim.x * 4) {
    float4* xr = (float4*)(p.out + (size_t)row * 1024);
    float4 v[4]; float ss = 0.f;
#pragma unroll
    for (int q = 0; q < 4; ++q) { v[q] = xr[q * 64 + lane]; ss += v[q].x * v[q].x + v[q].y * v[q].y + v[q].z * v[q].z + v[q].w * v[q].w; }
#pragma unroll
    for (int o = 32; o >= 1; o >>= 1) ss += __shfl_xor(ss, o);
    const float rstd = rsqrtf(ss * (1.f / 1024.f) + 1e-6f);
#pragma unroll
    for (int q = 0; q < 4; ++q) {
      const float4 g = ((const float4*)p.final_norm)[q * 64 + lane];
      float4 r; r.x = v[q].x * rstd * g.x; r.y = v[q].y * rstd * g.y; r.z = v[q].z * rstd * g.z; r.w = v[q].w * rstd * g.w;
      xr[q * 64 + lane] = r;
    }
  }
}


DI void run_phase(const Params& p, int ph, char* smem) {
  const int bid = obid(), nbk = gridDim.x;
  if (ph == 0) { prep_phase(p, smem); return; }
  if (ph == NPH - 1) { final_phase(p); return; }
  int q = ph - 1, layer, sub;
  if (q < 3) { layer = 0; sub = q; } else if (q < 15) { layer = 1; sub = q - 3; } else if (q < 18) { layer = 2; sub = q - 15; } else { layer = 3; sub = q - 18; }
  const int li = layer >> 1;
  const float* xcp = layer == 0 ? p.xp : p.out;
  const float* xcs = layer == 0 ? p.xs : p.out + (size_t)16384 * 1024;
  if ((layer & 1) == 0) {
    if (sub == 0) {
      const int ngemm = 640 * 26, nfilt = 5120;
      const bf16_t* Wt = p.wt_ain + (size_t)li * 3328 * 1024;
      gemm_run<1, 0>(p, bid, ngemm, nbk, 26, 0, xcp, xcs, nullptr, Wt, smem);
      for (int j = ngemm + ((bid + nbk - (ngemm % nbk)) % nbk); j < ngemm + nfilt; j += nbk) {
        {
          const int f = j - ngemm;
          if (f < 4096) filt_job(p, li, 0, (f >> 5) & 1, f & 31, f >> 6, smem);
          else { const int f2 = f - 4096; filt_job(p, li, 1, (f2 >> 5) & 1, f2 & 31, f2 >> 6, smem); }
        }
      }
    } else if (sub == 1) {
      const int nhy = 2560, natt = 5120;
      for (int j = bid; j < nhy + natt; j += nbk) {
        if (j < nhy) { const int c_ = j < 512 ? j : (j - 512) >> 2; const int g_ = j < 512 ? 0 : 1 + ((j - 512) & 3);
          if (j < 512) hyena_job<false>(p, li, c_, g_, smem); else hyena_job<true>(p, li, c_, g_, smem); }
        else { for (int rep = 0; rep < REP_ATT; ++rep) attn_even_job(p, li, j - nhy); }
      }
    } else {
      const bf16_t* Wt = p.wt_aout + (size_t)li * 1024 * 1024;
      const bf16_t* A = (const bf16_t*)(p.R + MIX_OFF);
      gemm_run<2, 2>(p, bid, 640 * 8, nbk, 8, 0, xcp, xcs, A, Wt, smem);
    }
  } else {
    const bf16_t* Wi = p.wt_cin + (size_t)li * 10240 * 1024;
    const bf16_t* Wo = p.wt_cout + (size_t)li * 1024 * 1024;
    int c1 = -1, c2 = -1, c3 = -1, c4 = -1;
    if (sub == 0) c1 = 0;
    else if (sub == 1) c2 = 0;
    else {
      const int ch = (sub - 2) >> 1;
      if (((sub - 2) & 1) == 0) { c3 = ch; if (ch < 4) c1 = ch + 1; }
      else { c4 = ch; if (ch < 4) c2 = ch + 1; }
    }
    if (c3 >= 0) merge_phase(p, c3);
    if (c4 >= 0) gemm_run<1, 2>(p, bid, 128 * 8, nbk, 8, c4 * CH, xcp, xcs, (const bf16_t*)(p.R + Y_OFF), Wo, smem);
    if (c1 >= 0) gemm_run<1, 1>(p, bid, 128 * 80, nbk, 80, c1 * CH, xcp, xcs, nullptr, Wi, smem);
    if (c2 >= 0) { for (int j = bid; j < 3072; j += nbk) attn_odd_job(p, c2, j); }
  }
}

#if MULTI_LAUNCH
__global__ void __launch_bounds__(256, 2) phase_kernel(Params p, int ph) {
  __shared__ __attribute__((aligned(16))) char smem[74240];
  run_phase(p, ph, smem);
}
#else
__global__ void __launch_bounds__(256, 2) mega_kernel(Params p) {
  __shared__ __attribute__((aligned(16))) char smem[74240];
  __shared__ uint4 xb_words;
  cg::grid_group grid = cg::this_grid();
  if (threadIdx.x == 0) xb_words = make_uint4(0u, 0u, 0u, 0u);
  __syncthreads();
  XcdBarrier xb = xcd_barrier_post(p.bar, (volatile LAS unsigned*)&xb_words);
#pragma unroll 1
  for (int ph = 0; ph < NPH; ++ph) {
    run_phase(p, ph, smem);
    if (p.bar == nullptr) grid.sync();
    if (ph + 1 < NPH) xcd_barrier(xb);
  }
}
#endif

extern "C" void kernel_launch(void* const* d_in, const int* in_sizes, int n_in, void* d_out, int out_size,
                              void* d_ws, size_t ws_size, hipStream_t stream) {
  Params p{};
  p.xp = (const float*)d_in[0]; p.xs = (const float*)d_in[1];
  p.a_norm = (const float*)d_in[2]; p.a_w_in = (const float*)d_in[3]; p.a_conv_w = (const float*)d_in[4]; p.a_conv_b = (const float*)d_in[5];
  p.fw1 = (const float*)d_in[6]; p.fb1 = (const float*)d_in[7]; p.ff1 = (const float*)d_in[8]; p.fw2 = (const float*)d_in[9];
  p.fb2 = (const float*)d_in[10]; p.ff2 = (const float*)d_in[11]; p.fw3 = (const float*)d_in[12]; p.hyd = (const float*)d_in[13];
  p.sink = (const float*)d_in[14]; p.a_w_out = (const float*)d_in[15]; p.c_norm = (const float*)d_in[16]; p.c_w_in = (const float*)d_in[17];
  p.c_w_out = (const float*)d_in[18]; p.final_norm = (const float*)d_in[19];
  p.out = (float*)d_out;
  char* ws = (char*)d_ws;
  size_t off = 0;
  p.wt_ain = (bf16_t*)(ws + off); off += (size_t)2 * 3328 * 1024 * 2;
  p.wt_cin = (bf16_t*)(ws + off); off += (size_t)2 * 10240 * 1024 * 2;
  p.wt_aout = (bf16_t*)(ws + off); off += (size_t)2 * 1024 * 1024 * 2;
  p.wt_cout = (bf16_t*)(ws + off); off += (size_t)2 * 1024 * 1024 * 2;
  p.hid = (float*)(ws + off); off += (size_t)2 * HID_PER_LAYER * 4;
  p.bar = (unsigned*)(ws + off); off += 16384;
  p.R = ws + off;
  const size_t need = off + (EVEN_END > ODD_END ? EVEN_END : ODD_END);
  if (need > ws_size) { fprintf(stderr, "workspace too small: need %zu have %zu\n", need, ws_size); return; }
#if MULTI_LAUNCH
  for (int ph = 0; ph < NPH; ++ph) hipLaunchKernelGGL(phase_kernel, dim3(1024), dim3(256), 0, stream, p, ph);
#else
  static int grid_blocks = 0;
  if (!grid_blocks) {
    int dev = 0, cus = 0, per_cu = 0;
    (void)hipGetDevice(&dev);
    (void)hipDeviceGetAttribute(&cus, hipDeviceAttributeMultiprocessorCount, dev);
    (void)hipOccupancyMaxActiveBlocksPerMultiprocessor(&per_cu, mega_kernel, 256, 0);
    if (per_cu < 1) per_cu = 1;
    if (per_cu > 2) per_cu = 2;
    grid_blocks = cus * per_cu;
  }
  (void)hipMemsetAsync(p.bar, 0, XCD_BAR_WORDS * 4, stream);
  void* args[] = {&p};
  hipError_t e = hipLaunchCooperativeKernel((void*)mega_kernel, dim3(grid_blocks), dim3(256), args, 0, stream);
  if (e != hipSuccess) fprintf(stderr, "cooperative launch failed: %s (grid %d)\n", hipGetErrorString(e), grid_blocks);
#endif
}
```

```cpp
#include <hip/hip_runtime.h>
#include <hip/hip_cooperative_groups.h>
#include <cstdio>
namespace cg = cooperative_groups;

typedef __attribute__((ext_vector_type(8))) short bf16x8;
typedef __attribute__((ext_vector_type(16))) float f32x16;
typedef __attribute__((ext_vector_type(4))) float f32x4;
typedef __attribute__((ext_vector_type(4))) unsigned u32x4;
typedef __attribute__((ext_vector_type(2))) unsigned u32x2;
typedef unsigned short bf16_t;

#define DI __device__ __forceinline__
#define MFMA32(a, b, c) __builtin_amdgcn_mfma_f32_32x32x16_bf16((a), (b), (c), 0, 0, 0)

#ifndef REP_GIN
#define REP_GIN 1
#endif
#ifndef REP_HY
#define REP_HY 1
#endif
#ifndef REP_ATT
#define REP_ATT 1
#endif
#ifndef REP_FILT
#define REP_FILT 1
#endif
#ifndef MULTI_LAUNCH
#define MULTI_LAUNCH 0
#endif

static constexpr int NT = 81920;
static constexpr int CH = 16384;
static constexpr int NPH = 32;
static constexpr float LOG2E = 1.4426950408889634f;
static constexpr int HID_PER_LAYER = 64 * 16384 + 64 * 4096;

static constexpr size_t U_OFF = 0;
static constexpr size_t HG_OFF = U_OFF + (size_t)1536 * NT * 2;
static constexpr size_t Q_OFF = HG_OFF + (size_t)512 * NT * 2;
static constexpr size_t K_OFF = Q_OFF + (size_t)NT * 512 * 2;
static constexpr size_t VT_OFF = K_OFF + (size_t)NT * 128 * 2;
static constexpr size_t AG_OFF = VT_OFF + (size_t)128 * NT * 2;
static constexpr size_t GSTR_P = 2 * 16384 + 8;
static constexpr size_t GSTR_S = 2 * 4096 + 8;
static constexpr size_t GAP_OFF = AG_OFF + (size_t)NT * 512 * 2;
static constexpr size_t GBP_OFF = GAP_OFF + (size_t)1024 * GSTR_P * 2;
static constexpr size_t GAS_OFF = GBP_OFF + (size_t)1024 * GSTR_P * 2;
static constexpr size_t GBS_OFF = GAS_OFF + (size_t)1024 * GSTR_S * 2;
static constexpr size_t MIX_OFF = (GBS_OFF + (size_t)1024 * GSTR_S * 2 + 255) & ~(size_t)255;
static constexpr size_t ATO_OFF = MIX_OFF + (size_t)512 * NT * 2;
static constexpr size_t XBE_OFF = MIX_OFF;
static constexpr size_t EVEN_END = MIX_OFF + (size_t)NT * 1024 * 2;
static constexpr size_t XB_OFF = 0;
static constexpr size_t QO_OFF = (size_t)NT * 1024 * 2;
static constexpr size_t KO_OFF = QO_OFF + (size_t)3 * CH * 1024 * 2;
static constexpr size_t VTO_OFF = KO_OFF + (size_t)3 * CH * 1024 * 2;
static constexpr size_t GO_OFF = VTO_OFF + (size_t)3 * CH * 1024 * 2;
static constexpr size_t OG_OFF = GO_OFF + (size_t)2 * CH * 1024 * 2;
static constexpr size_t LSE_OFF = OG_OFF + (size_t)3 * CH * 1024 * 2;
static constexpr size_t Y_OFF = LSE_OFF + (size_t)3 * CH * 8 * 4;
static constexpr size_t ODD_END = Y_OFF + (size_t)CH * 1024 * 2;

struct Params {
  const float *xp, *xs;
  const float *a_norm, *a_w_in, *a_conv_w, *a_conv_b, *fw1, *fb1, *ff1, *fw2, *fb2, *ff2, *fw3, *hyd, *sink, *a_w_out;
  const float *c_norm, *c_w_in, *c_w_out, *final_norm;
  float* out;
  bf16_t *wt_ain, *wt_cin, *wt_aout, *wt_cout;
  float* hid;
  char* R;
  unsigned* bar;
};

DI unsigned short f2bf(float x) { unsigned u = __float_as_uint(x); u += 0x7fffu + ((u >> 16) & 1u); return (unsigned short)(u >> 16); }
DI float bf2f(unsigned short b) { return __uint_as_float(((unsigned)b) << 16); }
DI unsigned pack2(float a, float b) { unsigned r; asm("v_cvt_pk_bf16_f32 %0, %1, %2" : "=v"(r) : "v"(a), "v"(b)); return r; }
DI float bflo(unsigned w) { return __uint_as_float(w << 16); }
DI float bfhi(unsigned w) { return __uint_as_float(w & 0xffff0000u); }
typedef __attribute__((ext_vector_type(2))) __bf16 bf2_t;
DI float dot2sq(unsigned w, float c) { const bf2_t v = __builtin_bit_cast(bf2_t, w); return __builtin_amdgcn_fdot2_f32_bf16(v, v, c, false); }
DI float xhalf_max(float x) { const unsigned u = __float_as_uint(x); auto r = __builtin_amdgcn_permlane32_swap(u, u, false, false); return fmaxf(__uint_as_float(r[0]), __uint_as_float(r[1])); }
DI float dpp_f(float x, int ctrl_sel) {
  const int b = __float_as_int(x);
  return __int_as_float(ctrl_sel == 0 ? __builtin_amdgcn_update_dpp(0, b, 0xB1, 0xF, 0xF, true)
                       : ctrl_sel == 1 ? __builtin_amdgcn_update_dpp(0, b, 0x4E, 0xF, 0xF, true)
                                       : __builtin_amdgcn_update_dpp(0, b, 0x141, 0xF, 0xF, true));
}
DI int otid() { int t = threadIdx.x; asm volatile("" : "+v"(t)); return t; }
DI int obid() { int t = blockIdx.x; asm volatile("" : "+s"(t)); return t; }
DI int seq_start_of(int tok) { return tok < 16384 ? 0 : (16384 + ((tok - 16384) & ~4095)); }
DI float silu(float x) { return x / (1.f + __expf(-x)); }
DI void store4bf(bf16_t* dst, const float (&v)[4]) { u32x2 w; w[0] = pack2(v[0], v[1]); w[1] = pack2(v[2], v[3]); *(u32x2*)dst = w; }


#define XB_TMO      128
#define XB_XCNT(j)  (256  + 64 * (j))
#define XB_XSUB(j)  (1280 + 64 * (j))
#define XB_XGEN(j)  (2304 + 64 * (j))
#define XB_TOP      3328
#define XB_TOPGEN   3392
#define XCD_BAR_WORDS 3456
#define XB_SPIN_CAP (1u << 22)
#define LAS __attribute__((address_space(3)))
DI unsigned xb_ld(unsigned* p) { return __hip_atomic_load(p, __ATOMIC_RELAXED, __HIP_MEMORY_SCOPE_AGENT); }
DI unsigned xb_add(unsigned* p, unsigned v) { return __hip_atomic_fetch_add(p, v, __ATOMIC_RELAXED, __HIP_MEMORY_SCOPE_AGENT); }
DI unsigned xb_xcc_id() { return (unsigned)__builtin_amdgcn_s_getreg((3 << 11) | 20) & 0xFu; }
#define XB_SPIN(cond, bar) do { unsigned _sp = 0; while (cond) { __builtin_amdgcn_s_sleep(1); \
    if ((++_sp & 255u) == 0u) { if (xb_ld(&(bar)[XB_TMO])) break; if (_sp > XB_SPIN_CAP) { atomicAdd(&(bar)[XB_TMO], 1u); break; } } } } while (0)
struct XcdBarrier { unsigned* bar; unsigned x; volatile LAS unsigned* st; };
DI XcdBarrier xcd_barrier_post(unsigned* bar, volatile LAS unsigned* st) {
  XcdBarrier b; b.bar = bar; b.x = xb_xcc_id(); b.st = st;
  if (threadIdx.x == 0) (void)xb_add(&bar[XB_XCNT(b.x)], 1u);
  return b;
}
DI void xcd_barrier_complete(unsigned* bar, unsigned x, unsigned& nloc, unsigned& nx) {
  const unsigned G = gridDim.x * gridDim.y * gridDim.z;
  unsigned sum, cnt, mine, sp = 0u;
  for (;;) {
    sum = 0u; cnt = 0u; mine = 0u;
#pragma unroll
    for (unsigned j = 0; j < 16; ++j) { const unsigned c = xb_ld(&bar[XB_XCNT(j)]); sum += c; cnt += (c > 0u) ? 1u : 0u; mine = (j == x) ? c : mine; }
    if (sum == G) break;
    __builtin_amdgcn_s_sleep(1);
    if ((++sp & 255u) == 0u) { if (xb_ld(&bar[XB_TMO])) break; if (sp > XB_SPIN_CAP) { atomicAdd(&bar[XB_TMO], 1u); break; } }
  }
  nloc = mine > 0u ? mine : 1u; nx = cnt > 0u ? cnt : 1u;
}
DI void xcd_barrier(const XcdBarrier& b) {
  asm volatile("s_waitcnt vmcnt(0)" ::: "memory");
  __syncthreads();
  if (threadIdx.x == 0) {
    unsigned* bar = b.bar;
    __builtin_amdgcn_s_waitcnt(0);
    unsigned nloc = b.st[0], nx = b.st[1];
    if (nloc == 0u) { xcd_barrier_complete(bar, b.x, nloc, nx); b.st[0] = nloc; b.st[1] = nx; }
    const unsigned old = xb_add(&bar[XB_XSUB(b.x)], 1u);
    const unsigned gen = old / nloc;
    if (old + 1u == (gen + 1u) * nloc) {
      __builtin_amdgcn_fence(__ATOMIC_RELEASE, "agent");
      asm volatile("s_waitcnt vmcnt(0)" ::: "memory");
      const unsigned og = xb_add(&bar[XB_TOP], 1u);
      const unsigned tg = og / nx;
      if (og + 1u == (tg + 1u) * nx) xb_add(&bar[XB_TOPGEN], 1u);
      else XB_SPIN(xb_ld(&bar[XB_TOPGEN]) == tg, bar);
      __builtin_amdgcn_fence(__ATOMIC_ACQUIRE, "agent");
      xb_add(&bar[XB_XGEN(b.x)], 1u);
      asm volatile("s_waitcnt vmcnt(0)" ::: "memory");
    } else {
      XB_SPIN(xb_ld(&bar[XB_XGEN(b.x)]) == gen, bar);
      __builtin_amdgcn_fence(__ATOMIC_ACQUIRE, "agent");
      asm volatile("s_waitcnt vmcnt(0)" ::: "memory");
    }
  }
  __syncthreads();
}

DI void prep_phase(const Params& p, char* smem) {
  const int tid = threadIdx.x;
  for (int m = 0; m < 8; ++m) {
    const float* W; const float* g = nullptr; bf16_t* Wt; int N;
    const int i = m & 1;
    if (m < 2) { N = 3328; W = p.a_w_in + (size_t)i * 1024 * 3328; g = p.a_norm + i * 1024; Wt = p.wt_ain + (size_t)i * 3328 * 1024; }
    else if (m < 4) { N = 10240; W = p.c_w_in + (size_t)i * 1024 * 10240; g = p.c_norm + i * 1024; Wt = p.wt_cin + (size_t)i * 10240 * 1024; }
    else if (m < 6) { N = 1024; W = p.a_w_out + (size_t)i * 1024 * 1024; Wt = p.wt_aout + (size_t)i * 1024 * 1024; }
    else { N = 1024; W = p.c_w_out + (size_t)i * 1024 * 1024; Wt = p.wt_cout + (size_t)i * 1024 * 1024; }
    const int items = N * 128;
    for (int it = blockIdx.x * 256 + tid; it < items; it += gridDim.x * 256) {
      const int n = it % N, kg = it / N;
      float v[8];
#pragma unroll
      for (int j = 0; j < 8; ++j) { const int k = kg * 8 + j; v[j] = W[(size_t)k * N + n] * (g ? g[k] : 1.f); }
      u32x4 w; w[0] = pack2(v[0], v[1]); w[1] = pack2(v[2], v[3]); w[2] = pack2(v[4], v[5]); w[3] = pack2(v[6], v[7]);
      *(u32x4*)(Wt + (size_t)n * 1024 + kg * 8) = w;
    }
  }
  {
    bf16_t* xbe = (bf16_t*)(p.R + XBE_OFF);
    for (int it = blockIdx.x * 256 + tid; it < NT * 128; it += gridDim.x * 256) {
      const size_t e = (size_t)it * 8;
      const float* src = e < (size_t)16384 * 1024 ? p.xp + e : p.xs + (e - (size_t)16384 * 1024);
      const float4 a = *(const float4*)src, b = *(const float4*)(src + 4);
      u32x4 w; w[0] = pack2(a.x, a.y); w[1] = pack2(a.z, a.w); w[2] = pack2(b.x, b.y); w[3] = pack2(b.z, b.w);
      *(u32x4*)(xbe + e) = w;
    }
  }
  float* sF = (float*)smem;
  float* sH = sF + 4 * 36;
  const int tl = tid >> 6, j = tid & 63;
  for (int item = blockIdx.x; item < 2 * 20480 / 4; item += gridDim.x) {
    const int gt = item * 4 + tl;
    const int li = gt / 20480, rem = gt % 20480;
    const int Lidx = rem >= 16384 ? 1 : 0;
    const int t = Lidx ? rem - 16384 : rem;
    const int L = Lidx ? 4096 : 16384;
    if (j < 33) {
      float f;
      if (j == 0) f = (float)t / (float)(L - 1);
      else {
        const int b = (j - 1) & 15;
        const float band = 1e-4f + (float)b * ((15.f - 1e-4f) / 15.f);
        const float wpos = 6.283185307179586f * (float)t / (float)L;
        const float a = band * wpos;
        f = (j <= 16) ? cosf(a) : -sinf(a);
      }
      sF[tl * 36 + j] = f;
    }
    __syncthreads();
    {
      const float* w1 = p.fw1 + li * 33 * 64;
      float a = p.fb1[li * 64 + j];
      for (int e = 0; e < 33; ++e) a += sF[tl * 36 + e] * w1[e * 64 + j];
      sH[tl * 64 + j] = sinf(p.ff1[li * 64 + j] * a);
    }
    __syncthreads();
    {
      const float* w2 = p.fw2 + li * 64 * 64;
      float a = p.fb2[li * 64 + j];
      for (int e = 0; e < 64; ++e) a += sH[tl * 64 + e] * w2[e * 64 + j];
      const float h2 = sinf(p.ff2[li * 64 + j] * a);
      p.hid[(size_t)li * HID_PER_LAYER + (Lidx ? 64 * 16384 : 0) + (size_t)j * L + t] = h2;
    }
    __syncthreads();
  }
}

DI void filt_job(const Params& p, int li, int Lidx, int o, int cg, int tch, char* smem) {
  const int tid = otid();
  const int L = Lidx ? 4096 : 16384;
  const int c0 = cg * 16;
  const float* hid = p.hid + (size_t)li * HID_PER_LAYER + (Lidx ? 64 * 16384 : 0);
  const float* w3 = p.fw3 + (size_t)li * 64 * 2048;
  float* sW = (float*)smem;
  __syncthreads();
  for (int e = tid; e < 64 * 32; e += 256) {
    const int jj = e >> 5, cc = e & 31;
    sW[e] = w3[jj * 2048 + (o * 2 + (cc >> 4)) * 512 + c0 + (cc & 15)];
  }
  __syncthreads();
  const int t = tch * 256 + tid;
  float acc[32];
#pragma unroll
  for (int i = 0; i < 32; ++i) acc[i] = 0.f;
#pragma unroll 4
  for (int jj = 0; jj < 64; ++jj) {
    const float hv = hid[(size_t)jj * L + t];
#pragma unroll
    for (int q = 0; q < 8; ++q) {
      const float4 w = *(const float4*)(sW + jj * 32 + 4 * q);
      acc[4 * q + 0] += hv * w.x; acc[4 * q + 1] += hv * w.y; acc[4 * q + 2] += hv * w.z; acc[4 * q + 3] += hv * w.w;
    }
  }
  const size_t gstr = Lidx ? GSTR_S : GSTR_P;
  bf16_t* GA = (bf16_t*)(p.R + (Lidx ? GAS_OFF : GAP_OFF)) + (size_t)(o * 512 + c0) * gstr;
  bf16_t* GB = (bf16_t*)(p.R + (Lidx ? GBS_OFF : GBP_OFF)) + (size_t)(o * 512 + c0) * gstr;
  const float min_decay = -3.0701134573253945f, max_decay = -15.350567286626973f;
  const float tl = (float)t / (float)(L - 1);
#pragma unroll
  for (int cc = 0; cc < 16; ++cc) {
    const float delta = fabsf(min_decay + (float)(c0 + cc) * ((max_decay - min_decay) / 511.f));
    const float win = expf(-tl * delta) + 0.05f;
    const float f = acc[cc] * win, bk = acc[16 + cc] * win;
    bf16_t* ga = GA + (size_t)cc * gstr;
    bf16_t* gb = GB + (size_t)cc * gstr;
    if (t == 0) {
      const bf16_t v = f2bf(f + bk);
      ga[L] = v; gb[L - 1] = v;
      ga[0] = 0;
    } else {
      const bf16_t vf = f2bf(f), vb = f2bf(bk);
      ga[L - t] = vf; gb[L - t - 1] = vf;
      ga[L + t] = vb; gb[L + t - 1] = vb;
    }
  }
}

template <int HALF>
DI void rope4(float (&v)[4], int lr, int pos0) {
  const int idx = lr & (HALF - 1);
  const float inv = exp2f(-((float)idx / (float)HALF) * 18.931568569324174f);
#pragma unroll
  for (int k = 0; k < 4; ++k) {
    const float pv = __shfl_xor(v[k], HALF);
    const float ang = (float)(pos0 + k) * inv;
    const float n = __builtin_rintf(ang * 0.15915494309189535f);
    float r = __builtin_fmaf(-n, 6.28318548202514648f, ang);
    r = __builtin_fmaf(-n, -1.7484555e-7f, r);
    const float fr = r * 0.15915494309189535f;
    const float s = __builtin_amdgcn_sinf(fr), c = __builtin_amdgcn_cosf(fr);
    if (lr < HALF) v[k] = v[k] * c - pv * s;
    else if (lr < 2 * HALF) v[k] = v[k] * c + pv * s;
  }
}

template <int AMODE, int EPI>
DI void gemm_tile(const Params& p, int mt, int nt, int tok0, const float* xcp, const float* xcs,
                          const bf16_t* Ab, const bf16_t* Wt, char* smem) {
  bf16_t* sAB = (bf16_t*)smem;
  float* sR = (float*)(smem + 2 * 2 * 128 * 72 * 2);
  const int tid = otid(), lane = tid & 63, wave = tid >> 6;
  const int wm = wave >> 1, wn = wave & 1;
  const int lr = lane & 31, lh = lane >> 5;
  const int ar = tid >> 4, ac = (tid & 15) * 4;
  const int br = tid >> 3, bc = (tid & 7) * 8;
  const float* arow_f = nullptr; const bf16_t* arow_b = nullptr;
  if (AMODE == 0) {
    const int tokA = tok0 + mt * 128 + ar;
    arow_f = (tokA < 16384 ? xcp + (size_t)tokA * 1024 : xcs + (size_t)(tokA - 16384) * 1024) + ac;
  } else if (AMODE == 1) {
    arow_b = (EPI == 1 ? (const bf16_t*)(p.R + XB_OFF) + (size_t)tok0 * 1024 : (EPI == 0 ? (const bf16_t*)(p.R + XBE_OFF) + (size_t)tok0 * 1024 : Ab)) + (size_t)(mt * 128 + br) * 1024 + bc;
  } else {
    arow_b = (const bf16_t*)(p.R + MIX_OFF) + (size_t)(tid & 63) * NT + tok0 + mt * 128 + 8 * (tid >> 6);
  }
  const bf16_t* ato_b = (const bf16_t*)(p.R + ATO_OFF) + (size_t)(tok0 + mt * 128 + br) * 512 + bc;
  const bf16_t* brow = Wt + (size_t)(nt * 128 + br) * 1024 + bc;
  f32x16 acc[2][2];
#pragma unroll
  for (int a = 0; a < 2; ++a)
#pragma unroll
    for (int b = 0; b < 2; ++b)
#pragma unroll
      for (int i = 0; i < 16; ++i) acc[a][b][i] = 0.f;
  struct Regs { float4 af[AMODE == 0 ? 8 : 1]; u32x4 ab[AMODE == 0 ? 1 : 4]; u32x4 bb[4]; };
  Regs R0, R1;
  float ssq[8];
#pragma unroll
  for (int i = 0; i < 8; ++i) ssq[i] = 0.f;
  auto gload = [&](Regs& R, int kt_) {
    const int kt = kt_ < 16 ? kt_ : 15;
    const int ko = kt * 64;
    if (AMODE == 0) {
#pragma unroll
      for (int i = 0; i < 8; ++i) R.af[i] = *(const float4*)(arow_f + (size_t)i * 16 * 1024 + ko);
    } else if (AMODE == 1) {
#pragma unroll
      for (int i = 0; i < 4; ++i) R.ab[i] = *(const u32x4*)(arow_b + (size_t)i * 32 * 1024 + ko);
    } else {
      if (kt < 8) {
#pragma unroll
        for (int i = 0; i < 4; ++i) R.ab[i] = *(const u32x4*)(arow_b + (size_t)ko * NT + 32 * i);
      } else {
#pragma unroll
        for (int i = 0; i < 4; ++i) R.ab[i] = *(const u32x4*)(ato_b + (size_t)i * 32 * 512 + (ko - 512));
      }
    }
#pragma unroll
    for (int i = 0; i < 4; ++i) R.bb[i] = *(const u32x4*)(brow + (size_t)i * 32 * 1024 + ko);
  };
  auto lstore = [&](const Regs& R, int st, int kt) {
    bf16_t* sA = sAB + st * (2 * 128 * 72);
    bf16_t* sB = sA + 128 * 72;
    if (AMODE == 0) {
#pragma unroll
      for (int i = 0; i < 8; ++i) {
        ssq[i] += R.af[i].x * R.af[i].x + R.af[i].y * R.af[i].y + R.af[i].z * R.af[i].z + R.af[i].w * R.af[i].w;
        u32x2 w; w[0] = pack2(R.af[i].x, R.af[i].y); w[1] = pack2(R.af[i].z, R.af[i].w);
        *(u32x2*)(sA + (ar + 16 * i) * 72 + ac) = w;
      }
    } else if (AMODE == 2 && kt < 8) {
      const int kk = tid & 63, tq = tid >> 6;
#pragma unroll
      for (int i = 0; i < 4; ++i)
#pragma unroll
        for (int q = 0; q < 4; ++q) {
          sA[(8 * (tq + 4 * i) + 2 * q) * 72 + kk] = (bf16_t)(R.ab[i][q] & 0xffffu);
          sA[(8 * (tq + 4 * i) + 2 * q + 1) * 72 + kk] = (bf16_t)(R.ab[i][q] >> 16);
        }
    } else {
#pragma unroll
      for (int i = 0; i < 4; ++i) {
        if (AMODE == 1 && EPI != 2) { ssq[i] = dot2sq(R.ab[i][0], ssq[i]); ssq[i] = dot2sq(R.ab[i][1], ssq[i]); ssq[i] = dot2sq(R.ab[i][2], ssq[i]); ssq[i] = dot2sq(R.ab[i][3], ssq[i]); }
        *(u32x4*)(sA + (br + 32 * i) * 72 + bc) = R.ab[i];
      }
    }
#pragma unroll
    for (int i = 0; i < 4; ++i) *(u32x4*)(sB + (br + 32 * i) * 72 + bc) = R.bb[i];
  };
  auto compute = [&](int st) {
    const bf16_t* sA = sAB + st * (2 * 128 * 72);
    const bf16_t* sB = sA + 128 * 72;
#pragma unroll
    for (int ks = 0; ks < 4; ++ks) {
      bf16x8 a[2], b[2];
#pragma unroll
      for (int mi = 0; mi < 2; ++mi) a[mi] = *(const bf16x8*)(sA + (wm * 64 + mi * 32 + lr) * 72 + ks * 16 + lh * 8);
#pragma unroll
      for (int ni = 0; ni < 2; ++ni) b[ni] = *(const bf16x8*)(sB + (wn * 64 + ni * 32 + lr) * 72 + ks * 16 + lh * 8);
#pragma unroll
      for (int mi = 0; mi < 2; ++mi)
#pragma unroll
        for (int ni = 0; ni < 2; ++ni) acc[mi][ni] = MFMA32(a[mi], b[ni], acc[mi][ni]);
    }
  };
  __syncthreads();
  if (AMODE == 0) {
    gload(R0, 0);
    lstore(R0, 0, 0);
    gload(R0, 1);
    __syncthreads();
#pragma unroll 1
    for (int kt = 0; kt < 16; ++kt) {
      compute(kt & 1);
      if (kt + 1 < 16) lstore(R0, (kt + 1) & 1, kt + 1);
      gload(R0, kt + 2);
      __syncthreads();
    }
  } else {
    gload(R0, 0);
    gload(R1, 1);
    lstore(R0, 0, 0);
    gload(R0, 2);
    __syncthreads();
#pragma unroll 1
    for (int kt = 0; kt < 16; kt += 2) {
      compute(0);
      lstore(R1, 1, kt + 1);
      gload(R1, kt + 3);
      __syncthreads();
      compute(1);
      if (kt + 2 < 16) lstore(R0, 0, kt + 2);
      gload(R0, kt + 4);
      __syncthreads();
    }
  }
  if (AMODE == 0) {
#pragma unroll
    for (int i = 0; i < 8; ++i) {
      float v = ssq[i];
      v += __shfl_xor(v, 1); v += __shfl_xor(v, 2); v += __shfl_xor(v, 4); v += __shfl_xor(v, 8);
      if ((tid & 15) == 0) sR[ar + 16 * i] = rsqrtf(v * (1.f / 1024.f) + 1e-6f);
    }
    __syncthreads();
  } else if (AMODE == 1 && EPI != 2) {
#pragma unroll
    for (int i = 0; i < 4; ++i) {
      float v = ssq[i];
      v += __shfl_xor(v, 1); v += __shfl_xor(v, 2); v += __shfl_xor(v, 4);
      if ((tid & 7) == 0) sR[br + 32 * i] = rsqrtf(v * (1.f / 1024.f) + 1e-6f);
    }
    __syncthreads();
  }
  const int rowbase = mt * 128;
  if (EPI == 2) {
#pragma unroll
    for (int mi = 0; mi < 2; ++mi)
#pragma unroll
      for (int ni = 0; ni < 2; ++ni) {
        const int col = nt * 128 + wn * 64 + ni * 32 + lr;
#pragma unroll
        for (int gi = 0; gi < 4; ++gi) {
          const int row4 = wm * 64 + mi * 32 + 8 * gi + 4 * lh;
          const int tok = tok0 + rowbase + row4;
#pragma unroll
          for (int k = 0; k < 4; ++k) {
            const int tk = tok + k;
            const float* xr = (tk < 16384 ? xcp + (size_t)tk * 1024 : xcs + (size_t)(tk - 16384) * 1024);
            const float xn = xr[col] + acc[mi][ni][4 * gi + k];
            p.out[(size_t)tk * 1024 + col] = xn;
            ((bf16_t*)(p.R + (AMODE == 2 ? XB_OFF : XBE_OFF)))[(size_t)tk * 1024 + col] = f2bf(xn);
          }
        }
      }
    return;
  }
  bool colmajor; int ropehalf = 0; float scl = 1.f; int kind = 0; bf16_t* fbase = nullptr;
  bf16_t* dst; size_t dld;
  int sh = 0;
  if (EPI == 0) {
    const int tb = tok0 + rowbase;
    if (nt < 12) { colmajor = true; dst = (bf16_t*)(p.R + U_OFF) + (size_t)(nt * 128) * NT + tb; dld = NT; }
    else if (nt < 16) { colmajor = true; dst = (bf16_t*)(p.R + HG_OFF) + (size_t)((nt - 12) * 128) * NT + tb; dld = NT; }
    else if (nt < 20) { colmajor = false; ropehalf = 8; scl = 0.125f * LOG2E; dst = (bf16_t*)(p.R + Q_OFF) + (size_t)tb * 512 + (nt - 16) * 128; dld = 512; }
    else if (nt == 20) { colmajor = false; ropehalf = 8; kind = 1; fbase = (bf16_t*)(p.R + K_OFF); dst = nullptr; dld = 0; }
    else if (nt == 21) { colmajor = true; kind = 2; fbase = (bf16_t*)(p.R + VT_OFF); dst = nullptr; dld = 0; }
    else { colmajor = false; dst = (bf16_t*)(p.R + AG_OFF) + (size_t)tb * 512 + (nt - 22) * 128; dld = 512; }
  } else {
    if (nt >= 72) { colmajor = false; dst = (bf16_t*)(p.R + GO_OFF) + ((size_t)((tok0 >> 14) & 1) * CH + rowbase) * 1024 + (nt - 72) * 128; dld = 1024; }
    else {
      const int g = nt / 24, which = (nt % 24) / 8, head = nt & 7;
      if (which < 2) {
        colmajor = false; ropehalf = 16; scl = which == 0 ? (0.08838834764831845f * LOG2E) : 1.f;
        dst = (bf16_t*)(p.R + QO_OFF) + ((size_t)g * CH + rowbase) * 1024 + head * 128; dld = 1024;
        sh = g == 0 ? 0 : (g == 1 ? 2 : 4);
        if (which == 1) { kind = 1; fbase = (bf16_t*)(p.R + KO_OFF) + ((size_t)g * 8 + head) * CH * 128; }
      } else {
        colmajor = true; sh = g == 0 ? 0 : (g == 1 ? 2 : 4);
        kind = 2; fbase = (bf16_t*)(p.R + VTO_OFF) + ((size_t)g * 8 + head) * CH * 128; dst = nullptr; dld = 0;
      }
    }
  }
  bf16_t* sC = (bf16_t*)smem;
  const int pos_base = tok0 + rowbase - seq_start_of(tok0 + rowbase);
#pragma unroll
  for (int mi = 0; mi < 2; ++mi)
#pragma unroll
    for (int ni = 0; ni < 2; ++ni) {
      const int cl = wn * 64 + ni * 32 + lr;
#pragma unroll
      for (int gi = 0; gi < 4; ++gi) {
        const int row4 = wm * 64 + mi * 32 + 8 * gi + 4 * lh;
        float v[4];
#pragma unroll
        for (int k = 0; k < 4; ++k) v[k] = acc[mi][ni][4 * gi + k] * sR[row4 + k];
        if (ropehalf == 8) { if (ni == 0) rope4<8>(v, lr, pos_base + row4); }
        else if (ropehalf == 16) { if (wn == 0 && ni == 0) rope4<16>(v, lr, pos_base + row4); }
        if (colmajor) {
          u32x2 w; w[0] = pack2(v[0], v[1]); w[1] = pack2(v[2], v[3]);
          *(u32x2*)(sC + cl * 136 + row4) = w;
        } else {
          const unsigned w0 = pack2(v[0] * scl, v[1] * scl), w1 = pack2(v[2] * scl, v[3] * scl);
          sC[(row4 + 0) * 136 + cl] = (bf16_t)(w0 & 0xffffu); sC[(row4 + 1) * 136 + cl] = (bf16_t)(w0 >> 16);
          sC[(row4 + 2) * 136 + cl] = (bf16_t)(w1 & 0xffffu); sC[(row4 + 3) * 136 + cl] = (bf16_t)(w1 >> 16);
        }
      }
    }
  __syncthreads();
  const int Lq = (EPI == 0) ? 0 : (tok0 == 0 ? 16384 : 4096);
  const int Ls = Lq >> sh;
  const int seqoff = (EPI == 0) ? 0 : (rowbase & ~(Lq - 1));
  const int dmask = (1 << sh) - 1;
  if (kind == 0) {
#pragma unroll
    for (int i = 0; i < 8; ++i) {
      const int chunk = tid + 256 * i;
      const int a_ = chunk >> 4, c8 = (chunk & 15) * 8;
      const u32x4 w = *(const u32x4*)(sC + a_ * 136 + c8);
      *(u32x4*)(dst + (size_t)a_ * dld + c8) = w;
    }
  } else if (kind == 1) {
#pragma unroll
    for (int i = 0; i < 8; ++i) {
      const int chunk = tid + 256 * i;
      const int a_ = chunk >> 4, c8 = (chunk & 15) * 8;
      const u32x4 w = *(const u32x4*)(sC + a_ * 136 + c8);
      int vt, hsel, d8, KS;
      if (EPI == 0) { vt = tok0 + rowbase + a_; hsel = c8 >> 6; d8 = c8 & 63; KS = 4; }
      else { const int n = rowbase + a_ - seqoff; vt = seqoff + (n & dmask) * Ls + (n >> sh); hsel = 0; d8 = c8; KS = 8; }
      const int kk = vt & 31;
      const int rho = ((kk >> 3) & 1) * 16 + ((kk >> 2) & 1) * 8 + (kk >> 4) * 4 + (kk & 3);
      bf16_t* dk = fbase + (size_t)hsel * NT * 64 + ((size_t)((vt >> 5) * KS + (d8 >> 4)) * 64 + ((d8 >> 3) & 1) * 32 + rho) * 8;
      *(u32x4*)dk = w;
    }
  } else {
    const int nb_s = (rowbase - seqoff) >> sh;
    const int d = 1 << sh;
#pragma unroll
    for (int i = 0; i < 8; ++i) {
      const int chunk = tid + 256 * i;
      const int a_ = chunk >> 4, c16 = chunk & 15;
      u32x4 w; int v8;
      if (sh == 0) {
        w = *(const u32x4*)(sC + a_ * 136 + c16 * 8);
        v8 = (EPI == 0 ? tok0 : 0) + rowbase + c16 * 8;
      } else {
        const int r = sh == 2 ? (c16 >> 2) : c16;
        const int sg = sh == 2 ? (c16 & 3) : 0;
        const bf16_t* sp = sC + a_ * 136 + sg * 8 * d + r;
#pragma unroll
        for (int q = 0; q < 4; ++q) w[q] = (unsigned)sp[(2 * q) * d] | ((unsigned)sp[(2 * q + 1) * d] << 16);
        v8 = seqoff + r * Ls + nb_s + sg * 8;
      }
      const int hsel = EPI == 0 ? (a_ >> 6) : 0;
      const int dim = EPI == 0 ? (a_ & 63) : a_;
      const int DT = EPI == 0 ? 2 : 4;
      const int within = v8 & 31;
      bf16_t* dv = fbase + (size_t)hsel * NT * 64 + ((((size_t)(v8 >> 5) * DT + (dim >> 5)) * 2 + ((within >> 3) & 1)) * 64 + (within >> 4) * 32 + (dim & 31)) * 8;
      *(u32x4*)dv = w;
    }
  }
}

template <int AMODE, int EPI>
DI void gemm_run(const Params& p, int jfirst, int njobs, int jstride, int ntn, int tok0, const float* xcp, const float* xcs,
                 const bf16_t* Ab, const bf16_t* Wt, char* smem) {
  if (jfirst >= njobs) return;
  bf16_t* sAB = (bf16_t*)smem;
  float* sR = (float*)(smem + 2 * 2 * 128 * 72 * 2);
  const int tid = otid(), lane = tid & 63, wave = __builtin_amdgcn_readfirstlane(tid >> 6);
  const int wm = wave >> 1, wn = wave & 1;
  const int lr = lane & 31, lh = lane >> 5;
  const int ar = tid >> 4, ac = (tid & 15) * 4;
  const int br = tid >> 3, bc = (tid & 7) * 8;
  struct Ptrs { const char* a; const char* a2; const char* b; };
  const unsigned voffF = (unsigned)(ar * 1024 + ac) * 4u;
  const unsigned voffB = (unsigned)(br * 1024 + bc) * 2u;
  const unsigned voffH = ((unsigned)(tid >> 4) * (unsigned)NT + 8u * (unsigned)(tid & 15)) * 2u;
  const unsigned voffT = (unsigned)(br * 512 + bc) * 2u;
  auto setup = [&](int j, Ptrs& P) {
    const int mt = j / ntn, nt = j - mt * ntn;
    const int tokA = tok0 + mt * 128;
    P.a2 = nullptr;
    if (AMODE == 0) {
      P.a = (const char*)(tokA < 16384 ? xcp + (size_t)tokA * 1024 : xcs + (size_t)(tokA - 16384) * 1024);
    } else if (AMODE == 1) {
      P.a = (const char*)((EPI == 1 ? (const bf16_t*)(p.R + XB_OFF) + (size_t)tok0 * 1024 : (EPI == 0 ? (const bf16_t*)(p.R + XBE_OFF) + (size_t)tok0 * 1024 : Ab)) + (size_t)(mt * 128) * 1024);
    } else {
      P.a = (const char*)((const bf16_t*)(p.R + MIX_OFF) + tokA);
      P.a2 = (const char*)((const bf16_t*)(p.R + ATO_OFF) + (size_t)tokA * 512);
    }
    P.b = (const char*)(Wt + (size_t)(nt * 128) * 1024);
  };
  struct Regs { float4 af[AMODE == 0 ? 8 : 1]; u32x4 ab[AMODE == 0 ? 1 : 4]; u32x4 bb[4]; };
  Regs R0, R1;
  float ssq[8];
#pragma unroll
  for (int i = 0; i < 8; ++i) ssq[i] = 0.f;
  Ptrs Pc, Pn;
  bool hasn = false;
  auto gload = [&](Regs& R, int kv) {
    const bool nx = kv >= 16 && hasn;
    const int kt = kv >= 16 ? (hasn ? kv - 16 : 15) : kv;
    const char* pa = nx ? Pn.a : Pc.a;
    const char* pa2 = nx ? Pn.a2 : Pc.a2;
    const char* pb = nx ? Pn.b : Pc.b;
    const int ko = kt * 64;
    if (AMODE == 0) {
      const char* q = pa + (size_t)ko * 4;
#pragma unroll
      for (int i = 0; i < 8; ++i) R.af[i] = *(const float4*)(q + (size_t)i * 16 * 4096 + voffF);
    } else if (AMODE == 1) {
      const char* q = pa + (size_t)ko * 2;
#pragma unroll
      for (int i = 0; i < 4; ++i) R.ab[i] = *(const u32x4*)(q + (size_t)i * 32 * 2048 + voffB);
    } else {
      if (kt < 8) {
        const char* q = pa + (size_t)ko * NT * 2;
#pragma unroll
        for (int i = 0; i < 4; ++i) R.ab[i] = *(const u32x4*)(q + (size_t)i * 16 * NT * 2 + voffH);
      } else {
        const char* q = pa2 + (size_t)(ko - 512) * 2;
#pragma unroll
        for (int i = 0; i < 4; ++i) R.ab[i] = *(const u32x4*)(q + (size_t)i * 32 * 1024 + voffT);
      }
    }
    const char* qb = pb + (size_t)ko * 2;
#pragma unroll
    for (int i = 0; i < 4; ++i) R.bb[i] = *(const u32x4*)(qb + (size_t)i * 32 * 2048 + voffB);
  };
  auto lstore = [&](const Regs& R, int st, int kv) {
    const int kt = kv & 15;
    bf16_t* sA = sAB + st * (2 * 128 * 72);
    bf16_t* sB = sA + 128 * 72;
    if (AMODE == 0) {
#pragma unroll
      for (int i = 0; i < 8; ++i) {
        ssq[i] += R.af[i].x * R.af[i].x + R.af[i].y * R.af[i].y + R.af[i].z * R.af[i].z + R.af[i].w * R.af[i].w;
        u32x2 w; w[0] = pack2(R.af[i].x, R.af[i].y); w[1] = pack2(R.af[i].z, R.af[i].w);
        *(u32x2*)(sA + (ar + 16 * i) * 72 + ac) = w;
      }
    } else if (AMODE == 2 && kt < 8) {
#pragma unroll
      for (int i = 0; i < 4; ++i) *(u32x4*)((char*)sA + ((tid >> 4) + 16 * i) * 272 + (tid & 15) * 16) = R.ab[i];
    } else {
#pragma unroll
      for (int i = 0; i < 4; ++i) {
        if (AMODE == 1 && EPI != 2) { ssq[i] = dot2sq(R.ab[i][0], ssq[i]); ssq[i] = dot2sq(R.ab[i][1], ssq[i]); ssq[i] = dot2sq(R.ab[i][2], ssq[i]); ssq[i] = dot2sq(R.ab[i][3], ssq[i]); }
        *(u32x4*)(sA + (br + 32 * i) * 72 + bc) = R.ab[i];
      }
    }
#pragma unroll
    for (int i = 0; i < 4; ++i) *(u32x4*)(sB + (br + 32 * i) * 72 + bc) = R.bb[i];
  };
  const int l15 = lane & 15, kg = lane >> 4;
  f32x4 acc[4][4];
  typedef __attribute__((ext_vector_type(4))) short s16x4_t;
  auto compute = [&](int st, int ktile) {
    const bf16_t* sA = sAB + st * (2 * 128 * 72);
    const bf16_t* sB = sA + 128 * 72;
    const bool trA = (AMODE == 2) && (ktile < 8);
#pragma unroll
    for (int ks = 0; ks < 2; ++ks) {
      bf16x8 a[4], b[4];
      if (trA) {
        const char* tb = (const char*)sA + 272 * (32 * ks + 8 * kg + ((lane & 15) >> 2)) + 8 * (lane & 3);
#pragma unroll
        for (int mi = 0; mi < 4; ++mi) {
          const int c = 4 * wm + mi;
          const s16x4_t lo = __builtin_amdgcn_ds_read_tr16_b64_v4i16((__attribute__((address_space(3))) s16x4_t*)(tb + 32 * c));
          const s16x4_t hi = __builtin_amdgcn_ds_read_tr16_b64_v4i16((__attribute__((address_space(3))) s16x4_t*)(tb + 32 * c + 272 * 4));
          a[mi] = __builtin_shufflevector(lo, hi, 0, 1, 2, 3, 4, 5, 6, 7);
        }
      } else {
#pragma unroll
        for (int mi = 0; mi < 4; ++mi) a[mi] = *(const bf16x8*)(sA + (wm * 64 + mi * 16 + l15) * 72 + ks * 32 + kg * 8);
      }
#pragma unroll
      for (int ni = 0; ni < 4; ++ni) b[ni] = *(const bf16x8*)(sB + (wn * 64 + ni * 16 + l15) * 72 + ks * 32 + kg * 8);
#pragma unroll
      for (int mi = 0; mi < 4; ++mi)
#pragma unroll
        for (int ni = 0; ni < 4; ++ni) acc[mi][ni] = __builtin_amdgcn_mfma_f32_16x16x32_bf16(a[mi], b[ni], acc[mi][ni], 0, 0, 0);
    }
  };
  auto finish_rstd = [&]() {
    if (AMODE == 0) {
#pragma unroll
      for (int i = 0; i < 8; ++i) {
        float v = ssq[i];
        v += __shfl_xor(v, 1); v += __shfl_xor(v, 2); v += __shfl_xor(v, 4); v += __shfl_xor(v, 8);
        if ((tid & 15) == 0) sR[ar + 16 * i] = rsqrtf(v * (1.f / 1024.f) + 1e-6f);
        ssq[i] = 0.f;
      }
    } else if (AMODE == 1 && EPI != 2) {
#pragma unroll
      for (int i = 0; i < 4; ++i) {
        float v = ssq[i];
        v += dpp_f(v, 0); v += dpp_f(v, 1); v += dpp_f(v, 2);
        if ((tid & 7) == 0) sR[br + 32 * i] = rsqrtf(v * (1.f / 1024.f) + 1e-6f);
        ssq[i] = 0.f;
      }
    }
  };
  int jcur = jfirst;
  setup(jcur, Pc);
  __syncthreads();
  gload(R0, 0);
  if (AMODE != 0) gload(R1, 1);
  lstore(R0, 0, 0);
  gload(R0, AMODE == 0 ? 1 : 2);
  __syncthreads();
#pragma unroll 1
  for (;;) {
    const int jn = jcur + jstride;
    hasn = jn < njobs;
    if (hasn) setup(jn, Pn);
    const int mt = jcur / ntn, nt = jcur - mt * ntn;
    float zf = 0.f;
    asm volatile("" : "+v"(zf));
#pragma unroll
    for (int a_ = 0; a_ < 4; ++a_)
#pragma unroll
      for (int b_ = 0; b_ < 4; ++b_)
#pragma unroll
        for (int i = 0; i < 4; ++i) acc[a_][b_][i] = zf;
    __builtin_amdgcn_s_setprio(2);
    if (AMODE == 0) {
#pragma unroll 1
      for (int kt = 0; kt < 16; ++kt) {
        compute(kt & 1, kt);
        if (kt == 15) finish_rstd();
        lstore(R0, (kt + 1) & 1, kt + 1);
        gload(R0, kt + 2);
        __syncthreads();
      }
    } else {
#pragma unroll 1
      for (int kt = 0; kt < 16; kt += 2) {
        compute(0, kt);
        lstore(R1, 1, kt + 1);
        gload(R1, kt + 3);
        __syncthreads();
        compute(1, kt + 1);
        if (kt == 14) finish_rstd();
        lstore(R0, 0, kt + 2);
        gload(R0, kt + 4);
        __syncthreads();
      }
    }
    __builtin_amdgcn_s_setprio(0);
  const int rowbase = mt * 128;
  if (EPI == 2) {
    const float* xbase = (tok0 + rowbase) < 16384 ? xcp : xcs - (size_t)16384 * 1024;
#pragma unroll
    for (int mi = 0; mi < 4; ++mi) {
#pragma unroll
      for (int ni = 0; ni < 4; ++ni) {
        const int col = nt * 128 + wn * 64 + ni * 16 + l15;
        const int tok = tok0 + rowbase + wm * 64 + mi * 16 + 4 * kg;
#pragma unroll
        for (int k = 0; k < 4; ++k) {
          const unsigned off = (unsigned)(tok + k) * 1024u + (unsigned)col;
          const float xn = xbase[off] + acc[mi][ni][k];
          p.out[off] = xn;
          ((bf16_t*)(p.R + (AMODE == 2 ? XB_OFF : XBE_OFF)))[off] = f2bf(xn);
        }
      }
      __builtin_amdgcn_sched_barrier(0);
    }
  } else {
  bool colmajor; int ropehalf = 0; float scl = 1.f; int kind = 0; bf16_t* fbase = nullptr;
  bf16_t* dst; size_t dld;
  int sh = 0;
  if (EPI == 0) {
    const int tb = tok0 + rowbase;
    if (nt < 12) { colmajor = true; dst = (bf16_t*)(p.R + U_OFF) + (size_t)(nt * 128) * NT + tb; dld = NT; }
    else if (nt < 16) { colmajor = true; dst = (bf16_t*)(p.R + HG_OFF) + (size_t)((nt - 12) * 128) * NT + tb; dld = NT; }
    else if (nt < 20) { colmajor = false; ropehalf = 8; scl = 0.125f * LOG2E; dst = (bf16_t*)(p.R + Q_OFF) + (size_t)tb * 512 + (nt - 16) * 128; dld = 512; }
    else if (nt == 20) { colmajor = false; ropehalf = 8; kind = 1; fbase = (bf16_t*)(p.R + K_OFF); dst = nullptr; dld = 0; }
    else if (nt == 21) { colmajor = true; kind = 2; fbase = (bf16_t*)(p.R + VT_OFF); dst = nullptr; dld = 0; }
    else { colmajor = false; dst = (bf16_t*)(p.R + AG_OFF) + (size_t)tb * 512 + (nt - 22) * 128; dld = 512; }
  } else {
    if (nt >= 72) { colmajor = false; dst = (bf16_t*)(p.R + GO_OFF) + ((size_t)((tok0 >> 14) & 1) * CH + rowbase) * 1024 + (nt - 72) * 128; dld = 1024; }
    else {
      const int g = nt / 24, which = (nt % 24) / 8, head = nt & 7;
      if (which < 2) {
        colmajor = false; ropehalf = 16; scl = which == 0 ? (0.08838834764831845f * LOG2E) : 1.f;
        dst = (bf16_t*)(p.R + QO_OFF) + ((size_t)g * CH + rowbase) * 1024 + head * 128; dld = 1024;
        sh = g == 0 ? 0 : (g == 1 ? 2 : 4);
        if (which == 1) { kind = 1; fbase = (bf16_t*)(p.R + KO_OFF) + ((size_t)g * 8 + head) * CH * 128; }
      } else {
        colmajor = true; sh = g == 0 ? 0 : (g == 1 ? 2 : 4);
        kind = 2; fbase = (bf16_t*)(p.R + VTO_OFF) + ((size_t)g * 8 + head) * CH * 128; dst = nullptr; dld = 0;
      }
    }
  }
  bf16_t* sC = (bf16_t*)(smem + 2 * 128 * 72 * 2);
  const int pos_base = tok0 + rowbase - seq_start_of(tok0 + rowbase);
#pragma unroll
  for (int mi = 0; mi < 4; ++mi) {
    const int row4 = wm * 64 + mi * 16 + 4 * kg;
    float rs[4];
#pragma unroll
    for (int k = 0; k < 4; ++k) rs[k] = sR[row4 + k];
    float v[4][4];
#pragma unroll
    for (int ni = 0; ni < 4; ++ni)
#pragma unroll
      for (int k = 0; k < 4; ++k) v[ni][k] = acc[mi][ni][k] * rs[k];
    if (ropehalf == 8) {
      rope4<8>(v[0], l15, pos_base + row4);
    } else if (ropehalf == 16) {
      if (wn == 0) {
        const float inv = exp2f(-((float)l15 / 16.f) * 18.931568569324174f);
#pragma unroll
        for (int k = 0; k < 4; ++k) {
          const float ang = (float)(pos_base + row4 + k) * inv;
          const float n = __builtin_rintf(ang * 0.15915494309189535f);
          float r = __builtin_fmaf(-n, 6.28318548202514648f, ang);
          r = __builtin_fmaf(-n, -1.7484555e-7f, r);
          const float fr = r * 0.15915494309189535f;
          const float sn = __builtin_amdgcn_sinf(fr), cs = __builtin_amdgcn_cosf(fr);
          const float x1 = v[0][k], x2 = v[1][k];
          v[0][k] = x1 * cs - x2 * sn;
          v[1][k] = x2 * cs + x1 * sn;
        }
      }
    }
#pragma unroll
    for (int ni = 0; ni < 4; ++ni) {
      const int cl = wn * 64 + ni * 16 + l15;
      if (colmajor) {
        u32x2 w; w[0] = pack2(v[ni][0], v[ni][1]); w[1] = pack2(v[ni][2], v[ni][3]);
        *(u32x2*)(sC + cl * 136 + row4) = w;
      } else {
        const unsigned w0 = pack2(v[ni][0] * scl, v[ni][1] * scl), w1 = pack2(v[ni][2] * scl, v[ni][3] * scl);
        sC[(row4 + 0) * 136 + cl] = (bf16_t)(w0 & 0xffffu); sC[(row4 + 1) * 136 + cl] = (bf16_t)(w0 >> 16);
        sC[(row4 + 2) * 136 + cl] = (bf16_t)(w1 & 0xffffu); sC[(row4 + 3) * 136 + cl] = (bf16_t)(w1 >> 16);
      }
    }
    asm volatile("" ::: "memory");
  }
  __syncthreads();
  const int Lq = (EPI == 0) ? 0 : (tok0 == 0 ? 16384 : 4096);
  const int Ls = Lq >> sh;
  const int seqoff = (EPI == 0) ? 0 : (rowbase & ~(Lq - 1));
  const int dmask = (1 << sh) - 1;
  if (kind == 0) {
#pragma unroll 4
    for (int i = 0; i < 8; ++i) {
      const int chunk = tid + 256 * i;
      const int a_ = chunk >> 4, c8 = (chunk & 15) * 8;
      const u32x4 w = *(const u32x4*)(sC + a_ * 136 + c8);
      *(u32x4*)(dst + (size_t)a_ * dld + c8) = w;
    }
  } else if (kind == 1 && sh != 4) {
    const int KS = EPI == 0 ? 4 : 8;
#pragma unroll 4
    for (int i = 0; i < 8; ++i) {
      const int chunk = tid + 256 * i;
      const int rho = chunk & 31, lhd = (chunk >> 5) & 1, ksx = (chunk >> 6) & 7, blk = chunk >> 9;
      const int kap = ((rho >> 2) & 1) * 16 + (rho >> 4) * 8 + ((rho >> 3) & 1) * 4 + (rho & 3);
      const int a_ = sh == 0 ? 32 * blk + kap : 4 * kap + blk;
      const u32x4 w = *(const u32x4*)(sC + a_ * 136 + (ksx * 2 + lhd) * 8);
      const int hsel = EPI == 0 ? (ksx >> 2) : 0;
      const int ks = EPI == 0 ? (ksx & 3) : ksx;
      const int blockid = sh == 0 ? (((EPI == 0 ? tok0 : 0) + rowbase) >> 5) + blk
                                  : (seqoff + blk * Ls + ((rowbase - seqoff) >> sh)) >> 5;
      bf16_t* dk = fbase + (size_t)hsel * NT * 64 + ((size_t)(blockid * KS + ks) * 64 + lhd * 32 + rho) * 8;
      *(u32x4*)dk = w;
    }
  } else if (kind == 1) {
#pragma unroll 4
    for (int i = 0; i < 8; ++i) {
      const int chunk = tid + 256 * i;
      const int a_ = chunk >> 4, c8 = (chunk & 15) * 8;
      const u32x4 w = *(const u32x4*)(sC + a_ * 136 + c8);
      int vt, hsel, d8, KS;
      if (EPI == 0) { vt = tok0 + rowbase + a_; hsel = c8 >> 6; d8 = c8 & 63; KS = 4; }
      else { const int n = rowbase + a_ - seqoff; vt = seqoff + (n & dmask) * Ls + (n >> sh); hsel = 0; d8 = c8; KS = 8; }
      const int kk = vt & 31;
      const int rho = ((kk >> 3) & 1) * 16 + ((kk >> 2) & 1) * 8 + (kk >> 4) * 4 + (kk & 3);
      bf16_t* dk = fbase + (size_t)hsel * NT * 64 + ((size_t)((vt >> 5) * KS + (d8 >> 4)) * 64 + ((d8 >> 3) & 1) * 32 + rho) * 8;
      *(u32x4*)dk = w;
    }
  } else if (sh != 4) {
    const int DT = EPI == 0 ? 2 : 4;
#pragma unroll 4
    for (int i = 0; i < 8; ++i) {
      const int chunk = tid + 256 * i;
      const int d31 = chunk & 31, lhv = (chunk >> 5) & 1, sv = (chunk >> 6) & 1, dtx = (chunk >> 7) & 3, blk = chunk >> 9;
      const int a_ = dtx * 32 + d31;
      const int within = 16 * lhv + 8 * sv;
      u32x4 w; int blockid;
      if (sh == 0) {
        w = *(const u32x4*)(sC + a_ * 136 + 32 * blk + within);
        blockid = (((EPI == 0 ? tok0 : 0) + rowbase) >> 5) + blk;
      } else {
        const bf16_t* sp = sC + a_ * 136 + within * 4 + blk;
#pragma unroll
        for (int q = 0; q < 4; ++q) w[q] = (unsigned)sp[(2 * q) * 4] | ((unsigned)sp[(2 * q + 1) * 4] << 16);
        blockid = (seqoff + blk * Ls + ((rowbase - seqoff) >> sh)) >> 5;
      }
      const int hsel = EPI == 0 ? (dtx >> 1) : 0;
      const int dt = EPI == 0 ? (dtx & 1) : dtx;
      bf16_t* dv = fbase + (size_t)hsel * NT * 64 + ((((size_t)blockid * DT + dt) * 2 + sv) * 64 + lhv * 32 + d31) * 8;
      *(u32x4*)dv = w;
    }
  } else {
    const int nb_s = (rowbase - seqoff) >> sh;
    const int d = 1 << sh;
#pragma unroll 4
    for (int i = 0; i < 8; ++i) {
      const int chunk = tid + 256 * i;
      const int a_ = chunk >> 4, c16 = chunk & 15;
      u32x4 w; int v8;
      if (sh == 0) {
        w = *(const u32x4*)(sC + a_ * 136 + c16 * 8);
        v8 = (EPI == 0 ? tok0 : 0) + rowbase + c16 * 8;
      } else {
        const int r = sh == 2 ? (c16 >> 2) : c16;
        const int sg = sh == 2 ? (c16 & 3) : 0;
        const bf16_t* sp = sC + a_ * 136 + sg * 8 * d + r;
#pragma unroll
        for (int q = 0; q < 4; ++q) w[q] = (unsigned)sp[(2 * q) * d] | ((unsigned)sp[(2 * q + 1) * d] << 16);
        v8 = seqoff + r * Ls + nb_s + sg * 8;
      }
      const int hsel = EPI == 0 ? (a_ >> 6) : 0;
      const int dim = EPI == 0 ? (a_ & 63) : a_;
      const int DT = EPI == 0 ? 2 : 4;
      const int within = v8 & 31;
      bf16_t* dv = fbase + (size_t)hsel * NT * 64 + ((((size_t)(v8 >> 5) * DT + (dim >> 5)) * 2 + ((within >> 3) & 1)) * 64 + (within >> 4) * 32 + (dim & 31)) * 8;
      *(u32x4*)dv = w;
    }
  }
  }
    __syncthreads();
    if (!hasn) break;
    jcur = jn; Pc = Pn;
  }
}

template <int HD, bool EVEN>
DI void attn_wave(const bf16_t* __restrict__ Qb, int qs, const bf16_t* __restrict__ KFb,
                  const bf16_t* __restrict__ VFb, int Ls, int dil, int res, int s0, int R,
                  float m_init, float l_init, bf16_t* __restrict__ Ob, int os,
                  const bf16_t* __restrict__ Gb, int gs, float* __restrict__ lse_b) {
  const int lane = otid() & 63, lr = lane & 31, lh = lane >> 5;
  constexpr bool QREG = true;
  bf16x8 qf[QREG ? HD / 16 : 1];
  const bf16_t* qp = Qb + (size_t)((s0 + lr) * dil + res) * qs + lh * 8;
  if (QREG) {
#pragma unroll
    for (int ks = 0; ks < HD / 16; ++ks) qf[ks] = *(const bf16x8*)(qp + ks * 16);
  }
  f32x16 O[HD / 32];
#pragma unroll
  for (int dt = 0; dt < HD / 32; ++dt)
#pragma unroll
    for (int i = 0; i < 16; ++i) O[dt][i] = 0.f;
  float m = m_init;
  float l = (lh == 0) ? l_init : 0.f;
  const int qq = s0 + lr;
  const int kb_first = s0 - R < 0 ? 0 : s0 - R;
  for (int kb = s0 - R; kb <= s0 + R; kb += 32) {
    if (kb + 31 < 0 || kb >= Ls) continue;
    const bf16_t* kp = KFb + ((size_t)(kb >> 5) * (HD / 16) * 64 + lane) * 8;
    bf16x8 vfr[2][HD / 32];
    {
      const bf16_t* vp = VFb + ((size_t)(kb >> 5) * (HD / 32) * 2 * 64 + lane) * 8;
#pragma unroll
      for (int dt = 0; dt < HD / 32; ++dt)
#pragma unroll
        for (int s2 = 0; s2 < 2; ++s2) vfr[s2][dt] = *(const bf16x8*)(vp + (dt * 2 + s2) * 512);
    }
    f32x16 S;
#pragma unroll
    for (int i = 0; i < 16; ++i) S[i] = 0.f;
#pragma unroll
    for (int ks = 0; ks < HD / 16; ++ks) S = MFMA32(*(const bf16x8*)(kp + ks * 512), qf[ks], S);
    float mx = -1e30f;
    unsigned okm = 0;
    const bool interior = (kb >= s0 + 31 - R) && (kb <= s0 + R - 31) && (kb >= 0) && (kb + 32 <= Ls);
    if (interior) {
      okm = 0xFFFFu;
#pragma unroll
      for (int i = 0; i < 16; ++i) mx = fmaxf(mx, S[i]);
    } else {
#pragma unroll
      for (int i = 0; i < 16; ++i) {
        const int kk = kb + 16 * lh + i;
        int df = kk - qq; df = df < 0 ? -df : df;
        const bool ok = (kk >= 0) && (kk < Ls) && (df <= R);
        okm |= ok ? (1u << i) : 0u;
        S[i] = ok ? S[i] : -1e30f;
        mx = fmaxf(mx, S[i]);
      }
    }
    mx = xhalf_max(mx);
    const float mn = fmaxf(m, mx);
    const float alpha = __builtin_amdgcn_exp2f(m - mn);
    m = mn;
    float rs = 0.f;
#pragma unroll
    for (int i = 0; i < 16; ++i) {
      const float pe = ((okm >> i) & 1u) ? __builtin_amdgcn_exp2f(S[i] - mn) : 0.f;
      S[i] = pe; rs += pe;
    }
    l = l * alpha + rs;
    if (kb != kb_first) {
#pragma unroll
      for (int dt = 0; dt < HD / 32; ++dt)
#pragma unroll
        for (int i = 0; i < 16; ++i) O[dt][i] *= alpha;
    }
#pragma unroll
    for (int s = 0; s < 2; ++s) {
      u32x4 pw;
#pragma unroll
      for (int q = 0; q < 4; ++q) pw[q] = pack2(S[8 * s + 2 * q], S[8 * s + 2 * q + 1]);
      const bf16x8 pf = __builtin_bit_cast(bf16x8, pw);
#pragma unroll
      for (int dt = 0; dt < HD / 32; ++dt) {
        O[dt] = MFMA32(vfr[s][dt], pf, O[dt]);
      }
    }
  }
  const float lt = l + __shfl_xor(l, 32);
  const float inv = 1.f / lt;
  const size_t row = (size_t)((s0 + lr) * dil + res);
  if (!EVEN) { if (lh == 0) lse_b[row * 8] = m + __log2f(lt); }
#pragma unroll
  for (int dt = 0; dt < HD / 32; ++dt)
#pragma unroll
    for (int gi = 0; gi < 4; ++gi) {
      const int dim4 = dt * 32 + 8 * gi + 4 * lh;
      float v[4];
#pragma unroll
      for (int k = 0; k < 4; ++k) v[k] = O[dt][4 * gi + k] * inv;
      if (EVEN) {
        const u32x2 gw = *(const u32x2*)(Gb + row * gs + dim4);
        v[0] *= silu(bflo(gw[0])); v[1] *= silu(bfhi(gw[0])); v[2] *= silu(bflo(gw[1])); v[3] *= silu(bfhi(gw[1]));
      }
      store4bf(Ob + row * os + dim4, v);
    }
}

template <int HD, bool EVEN>
DI void attn_wave_db(const bf16_t* __restrict__ Qb, int qs, const bf16_t* __restrict__ KFb,
                  const bf16_t* __restrict__ VFb, int Ls, int dil, int res, int s0, int R,
                  float m_init, float l_init, bf16_t* __restrict__ Ob, int os,
                  const bf16_t* __restrict__ Gb, int gs, float* __restrict__ lse_b) {
  const int lane = otid() & 63, lr = lane & 31, lh = lane >> 5;
  constexpr bool QREG = true;
  bf16x8 qf[QREG ? HD / 16 : 1];
  const bf16_t* qp = Qb + (size_t)((s0 + lr) * dil + res) * qs + lh * 8;
  if (QREG) {
#pragma unroll
    for (int ks = 0; ks < HD / 16; ++ks) qf[ks] = *(const bf16x8*)(qp + ks * 16);
  }
  f32x16 O[HD / 32];
#pragma unroll
  for (int dt = 0; dt < HD / 32; ++dt)
#pragma unroll
    for (int i = 0; i < 16; ++i) O[dt][i] = 0.f;
  float m = m_init;
  float l = (lh == 0) ? l_init : 0.f;
  const int qq = s0 + lr;
  const int kb_first = s0 - R < 0 ? 0 : s0 - R;
  constexpr int KS = HD / 16, DT = HD / 32;
  auto kvload = [&](bf16x8 (&kf)[KS], bf16x8 (&vfr)[2][DT], int kb) {
    const bf16_t* kp = KFb + ((size_t)(kb >> 5) * KS * 64 + lane) * 8;
    const bf16_t* vp = VFb + ((size_t)(kb >> 5) * DT * 2 * 64 + lane) * 8;
#pragma unroll
    for (int ks = 0; ks < KS; ++ks) kf[ks] = *(const bf16x8*)(kp + ks * 512);
#pragma unroll
    for (int dt = 0; dt < DT; ++dt)
#pragma unroll
      for (int s2 = 0; s2 < 2; ++s2) vfr[s2][dt] = *(const bf16x8*)(vp + (dt * 2 + s2) * 512);
  };
  auto step = [&](const bf16x8 (&kf)[KS], const bf16x8 (&vfr)[2][DT], int kb) {
    f32x16 S;
#pragma unroll
    for (int i = 0; i < 16; ++i) S[i] = 0.f;
#pragma unroll
    for (int ks = 0; ks < HD / 16; ++ks) S = MFMA32(kf[ks], qf[ks], S);
    float mx = -1e30f;
    unsigned okm = 0;
    const bool interior = (kb >= s0 + 31 - R) && (kb <= s0 + R - 31) && (kb >= 0) && (kb + 32 <= Ls);
    if (interior) {
      okm = 0xFFFFu;
#pragma unroll
      for (int i = 0; i < 16; ++i) mx = fmaxf(mx, S[i]);
    } else {
#pragma unroll
      for (int i = 0; i < 16; ++i) {
        const int kk = kb + 16 * lh + i;
        int df = kk - qq; df = df < 0 ? -df : df;
        const bool ok = (kk >= 0) && (kk < Ls) && (df <= R);
        okm |= ok ? (1u << i) : 0u;
        S[i] = ok ? S[i] : -1e30f;
        mx = fmaxf(mx, S[i]);
      }
    }
    mx = xhalf_max(mx);
    const float mn = fmaxf(m, mx);
    const float alpha = __builtin_amdgcn_exp2f(m - mn);
    m = mn;
    float rs = 0.f;
#pragma unroll
    for (int i = 0; i < 16; ++i) {
      const float pe = ((okm >> i) & 1u) ? __builtin_amdgcn_exp2f(S[i] - mn) : 0.f;
      S[i] = pe; rs += pe;
    }
    l = l * alpha + rs;
    if (kb != kb_first) {
#pragma unroll
      for (int dt = 0; dt < HD / 32; ++dt)
#pragma unroll
        for (int i = 0; i < 16; ++i) O[dt][i] *= alpha;
    }
#pragma unroll
    for (int s = 0; s < 2; ++s) {
      u32x4 pw;
#pragma unroll
      for (int q = 0; q < 4; ++q) pw[q] = pack2(S[8 * s + 2 * q], S[8 * s + 2 * q + 1]);
      const bf16x8 pf = __builtin_bit_cast(bf16x8, pw);
#pragma unroll
      for (int dt = 0; dt < HD / 32; ++dt) {
        O[dt] = MFMA32(vfr[s][dt], pf, O[dt]);
      }
    }
  };
  const int kb_lo = s0 - R < 0 ? 0 : s0 - R;
  const int kb_hi = s0 + R > Ls - 32 ? Ls - 32 : s0 + R;
  {
    bf16x8 kA[KS], vA[2][DT], kB[KS], vB[2][DT];
    kvload(kA, vA, kb_lo);
    for (int kb = kb_lo; kb <= kb_hi; kb += 64) {
      kvload(kB, vB, kb + 32 <= kb_hi ? kb + 32 : kb_hi);
      step(kA, vA, kb);
      if (kb + 32 <= kb_hi) {
        kvload(kA, vA, kb + 64 <= kb_hi ? kb + 64 : kb_hi);
        step(kB, vB, kb + 32);
      }
    }
  }
  const float lt = l + __shfl_xor(l, 32);
  const float inv = 1.f / lt;
  const size_t row = (size_t)((s0 + lr) * dil + res);
  if (!EVEN) { if (lh == 0) lse_b[row * 8] = m + __log2f(lt); }
#pragma unroll
  for (int dt = 0; dt < HD / 32; ++dt)
#pragma unroll
    for (int gi = 0; gi < 4; ++gi) {
      const int dim4 = dt * 32 + 8 * gi + 4 * lh;
      float v[4];
#pragma unroll
      for (int k = 0; k < 4; ++k) v[k] = O[dt][4 * gi + k] * inv;
      if (EVEN) {
        const u32x2 gw = *(const u32x2*)(Gb + row * gs + dim4);
        v[0] *= silu(bflo(gw[0])); v[1] *= silu(bfhi(gw[0])); v[2] *= silu(bflo(gw[1])); v[3] *= silu(bfhi(gw[1]));
      }
      store4bf(Ob + row * os + dim4, v);
    }
}

DI void attn_even_job(const Params& p, int li, int bj) {
  const int wave = __builtin_amdgcn_readfirstlane(otid() >> 6);
  const int qt = bj >> 1, kvh = bj & 1;
  const int head = kvh * 4 + wave;
  const int tok0 = qt * 32;
  const int ss = seq_start_of(tok0);
  const int L = tok0 < 16384 ? 16384 : 4096;
  const bf16_t* Q = (const bf16_t*)(p.R + Q_OFF) + (size_t)ss * 512 + head * 64;
  const bf16_t* Kk = (const bf16_t*)(p.R + K_OFF) + ((size_t)kvh * NT + ss) * 64;
  const bf16_t* VT = (const bf16_t*)(p.R + VT_OFF) + ((size_t)kvh * NT + ss) * 64;
  bf16_t* Ob = (bf16_t*)(p.R + ATO_OFF) + (size_t)ss * 512 + head * 64;
  const bf16_t* Gb = (const bf16_t*)(p.R + AG_OFF) + (size_t)ss * 512 + head * 64;
  const float sink2 = p.sink[li * 8 + head] * LOG2E;
  attn_wave_db<64, true>(Q, 512, Kk, VT, L, 1, 0, tok0 - ss, 128, sink2, 1.f, Ob, 512, Gb, 512, nullptr);
}

DI void attn_odd_job(const Params& p, int ch, int bj) {
  const int wave = __builtin_amdgcn_readfirstlane(otid() >> 6);
  const int wj = bj * 4 + wave;
  const int g = wj >> 12, rem = wj & 4095;
  const int head = rem >> 9, tix = rem & 511;
  const int L = ch == 0 ? 16384 : 4096;
  const int sh = g == 0 ? 0 : (g == 1 ? 2 : 4);
  const int Ls = L >> sh;
  const int seqoff = (tix * 32) & ~(L - 1);
  const int w = tix * 32 - seqoff;
  const int r = w / Ls, s0 = w % Ls;
  const bf16_t* Q = (const bf16_t*)(p.R + QO_OFF) + ((size_t)g * CH + seqoff) * 1024 + head * 128;
  const bf16_t* Kk = (const bf16_t*)(p.R + KO_OFF) + (((size_t)g * 8 + head) * CH + seqoff + (size_t)r * Ls) * 128;
  const bf16_t* VT = (const bf16_t*)(p.R + VTO_OFF) + (((size_t)g * 8 + head) * CH + seqoff + (size_t)r * Ls) * 128;
  bf16_t* Ob = (bf16_t*)(p.R + OG_OFF) + ((size_t)g * CH + seqoff) * 1024 + head * 128;
  float* lse = (float*)(p.R + LSE_OFF) + ((size_t)g * CH + seqoff) * 8 + head;
  attn_wave<128, false>(Q, 1024, Kk, VT, Ls, 1 << sh, r, s0, 64, -1e30f, 0.f, Ob, 1024, nullptr, 0, lse);
}

DI void merge_phase(const Params& p, int ch) {
  const bf16_t* Og = (const bf16_t*)(p.R + OG_OFF);
  const float* lse = (const float*)(p.R + LSE_OFF);
  const bf16_t* Go = (const bf16_t*)(p.R + GO_OFF) + (size_t)(ch & 1) * CH * 1024;
  bf16_t* Y = (bf16_t*)(p.R + Y_OFF);
  for (int it = blockIdx.x * 256 + threadIdx.x; it < CH * 128; it += gridDim.x * 256) {
    const int tok = it >> 7, within = it & 127;
    const int head = within >> 4;
    const size_t off = (size_t)tok * 1024 + within * 8;
    float l0 = lse[(size_t)tok * 8 + head], l1 = lse[((size_t)CH + tok) * 8 + head], l2 = lse[((size_t)2 * CH + tok) * 8 + head];
    const float mx = fmaxf(l0, fmaxf(l1, l2));
    float w0 = __builtin_amdgcn_exp2f(l0 - mx), w1 = __builtin_amdgcn_exp2f(l1 - mx), w2 = __builtin_amdgcn_exp2f(l2 - mx);
    const float iv = 1.f / (w0 + w1 + w2);
    w0 *= iv; w1 *= iv; w2 *= iv;
    const u32x4 a = *(const u32x4*)(Og + off);
    const u32x4 b = *(const u32x4*)(Og + (size_t)CH * 1024 + off);
    const u32x4 c = *(const u32x4*)(Og + (size_t)2 * CH * 1024 + off);
    const u32x4 gg = *(const u32x4*)(Go + off);
    u32x4 y;
#pragma unroll
    for (int q = 0; q < 4; ++q) {
      const float lo = (w0 * bflo(a[q]) + w1 * bflo(b[q]) + w2 * bflo(c[q])) * silu(bflo(gg[q]));
      const float hi = (w0 * bfhi(a[q]) + w1 * bfhi(b[q]) + w2 * bfhi(c[q])) * silu(bfhi(gg[q]));
      y[q] = pack2(lo, hi);
    }
    *(u32x4*)(Y + off) = y;
  }
}

struct __attribute__((aligned(4))) U4a { unsigned v[4]; };

DI void sc4(const bf16_t* __restrict__ Uc, int n4, int lmask, float w0, float w1, float w2, float b, float (&o)[4]) {
  const u32x2 w = *(const u32x2*)(Uc + n4);
  const float u0 = bflo(w[0]), u1 = bfhi(w[0]), u2 = bflo(w[1]), u3 = bfhi(w[1]);
  const float um = (n4 & lmask) ? bf2f(Uc[n4 - 1]) : 0.f;
  const float up = ((n4 + 4) & lmask) ? bf2f(Uc[n4 + 4]) : 0.f;
  o[0] = w0 * um + w1 * u0 + w2 * u1 + b;
  o[1] = w0 * u0 + w1 * u1 + w2 * u2 + b;
  o[2] = w0 * u1 + w1 * u2 + w2 * u3 + b;
  o[3] = w0 * u2 + w1 * u3 + w2 * up + b;
}

template <bool SAMPLE>
DI void hyena_job(const Params& p, int li, int c, int grp, char* smem) {
  bf16_t* zl = (bf16_t*)smem;
  const int tid = otid(), lane = tid & 63, wave = __builtin_amdgcn_readfirstlane(tid >> 6), lr = lane & 31, lh = lane >> 5;
  const int tok0 = grp * 16384;
  constexpr int L = SAMPLE ? 4096 : 16384;
  constexpr int nb = L >> 6, lmask = L - 1;
  constexpr int PAD = SAMPLE ? 16 : 32;
  constexpr int SEQB = nb + 2 * PAD + (SAMPLE ? 8 : 0);
  constexpr int LSH = SAMPLE ? 12 : 14;
  const bf16_t* U = (const bf16_t*)(p.R + U_OFF);
  const bf16_t* Uv = U + (size_t)(1024 + c) * NT + tok0;
  const bf16_t* Ux1 = U + (size_t)c * NT + tok0;
  const bf16_t* Ux2 = U + (size_t)(512 + c) * NT + tok0;
  const bf16_t* HGc = (const bf16_t*)(p.R + HG_OFF) + (size_t)c * NT + tok0;
  bf16_t* HYC = (bf16_t*)(p.R + MIX_OFF) + (size_t)c * NT + tok0;
  const float* cw = p.a_conv_w + li * 3 * 1536;
  const float* cb = p.a_conv_b + li * 1536;
  __syncthreads();
  {
    constexpr int NSEQ = SAMPLE ? 4 : 1;
    for (int e = tid; e < NSEQ * 2 * PAD * 8; e += 256) {
      const int q = e / (2 * PAD * 8), r = e - q * (2 * PAD * 8);
      const int pb = r >> 3, part = r & 7;
      const int blk = q * SEQB + (pb < PAD ? pb : nb + pb);
      unsigned zu = 0u;
      asm volatile("" : "+v"(zu));
      u32x4 z; z[0] = zu; z[1] = zu; z[2] = zu; z[3] = zu;
      *(u32x4*)(zl + blk * 72 + part * 8) = z;
    }
    const float w0 = cw[1024 + c], w1 = cw[1536 + 1024 + c], w2 = cw[2 * 1536 + 1024 + c], b = cb[1024 + c];
    for (int n8 = tid; n8 < 2048; n8 += 256) {
      const int n = n8 * 8;
      float o0[4], o1[4];
      sc4(Uv, n, lmask, w0, w1, w2, b, o0);
      sc4(Uv, n + 4, lmask, w0, w1, w2, b, o1);
      u32x4 w; w[0] = pack2(o0[0], o0[1]); w[1] = pack2(o0[2], o0[3]); w[2] = pack2(o1[0], o1[1]); w[3] = pack2(o1[2], o1[3]);
      *(u32x4*)(zl + ((n >> LSH) * SEQB + PAD + ((n & lmask) >> 6)) * 72 + (n & 63)) = w;
    }
  }
  __syncthreads();
  constexpr size_t gstr = SAMPLE ? GSTR_S : GSTR_P;
  constexpr int span = SAMPLE ? 8 : 32;
  constexpr int DSH = span;
  constexpr int CTO = 0;
  constexpr int ctstep = DSH + CTO;
  const int i0w = SAMPLE ? 16 * wave : 64 * wave;
  const int sblk = (SAMPLE ? (lr >> 3) * SEQB : 0) + PAD;
  const int ilane = i0w + (SAMPLE ? (lr & 7) : lr);
  const int dlo = i0w - nb + 1;
  const int dhi = (i0w + DSH + span - 1 < nb - 1) ? i0w + DSH + span - 1 : nb - 1;
  for (int o = 0; o < 2; ++o) {
    const bf16_t* GA = (const bf16_t*)(p.R + (SAMPLE ? GAS_OFF : GAP_OFF)) + (size_t)(o * 512 + c) * gstr;
    const bf16_t* GB = (const bf16_t*)(p.R + (SAMPLE ? GBS_OFF : GBP_OFF)) + (size_t)(o * 512 + c) * gstr;
    const bf16_t* gbase = ((lr & 1) ? GB - 1 : GA) + (L - 32 - lr + 8 * lh);
    f32x16 acc[2][2];
#pragma unroll
    for (int a = 0; a < 2; ++a)
#pragma unroll
      for (int b = 0; b < 2; ++b)
#pragma unroll
        for (int i = 0; i < 16; ++i) acc[a][b][i] = 0.f;
    auto fload = [&](U4a (&P)[6], int d) {
      const int dc = d <= dhi ? d : dhi;
#pragma unroll
      for (int q = 0; q < 6; ++q) P[q] = *(const U4a*)(gbase - 64 * dc + 16 * q);
    };
    auto fcomp = [&](const U4a (&P)[6], int d) {
      if (d > dhi) return;
#pragma unroll
      for (int ct = 0; ct < 2; ++ct) {
        const int i0 = i0w + DSH * ct;
        const int lo_ = i0 - nb + 1, hi_ = (i0 + span - 1 < nb - 1) ? i0 + span - 1 : nb - 1;
        if (d < lo_ || d > hi_) continue;
        const int jb = ilane + DSH * ct - d;
        const bf16_t* zp = zl + (sblk + CTO * ct + jb) * 72 + 8 * lh;
#pragma unroll
        for (int ks = 0; ks < 4; ++ks) {
          const bf16x8 bfr = *(const bf16x8*)(zp + 16 * ks);
#pragma unroll
          for (int rt = 0; rt < 2; ++rt) acc[rt][ct] = MFMA32(__builtin_bit_cast(bf16x8, P[2 - 2 * rt + ks]), bfr, acc[rt][ct]);
        }
      }
    };
    auto fload4 = [&](U4a (&P)[6], int d) {
      const int dc = d <= dhi ? d : dhi;
#pragma unroll
      for (int q = 0; q < 4; ++q) P[q] = *(const U4a*)(gbase - 64 * dc + 16 * q);
    };
    U4a PA[6], PB[6];
    fload(PA, dlo);
    for (int d = dlo; d <= dhi; d += 2) {
      fload4(PB, d + 1);
      fcomp(PA, d);
      PB[4] = PA[0]; PB[5] = PA[1];
      fload4(PA, d + 2);
      fcomp(PB, d + 1);
      PA[4] = PB[0]; PA[5] = PB[1];
    }
    const float dco = p.hyd[li * 1024 + o * 512 + c];
    const int zoff = (sblk + ilane) * 72 + 4 * lh;
#pragma unroll
    for (int rt = 0; rt < 2; ++rt)
#pragma unroll
      for (int ct = 0; ct < 2; ++ct)
#pragma unroll
        for (int gi = 0; gi < 4; ++gi) {
          const u32x2 zw = *(const u32x2*)(zl + zoff + ct * ctstep * 72 + 32 * rt + 8 * gi);
          acc[rt][ct][4 * gi + 0] += dco * bflo(zw[0]); acc[rt][ct][4 * gi + 1] += dco * bfhi(zw[0]);
          acc[rt][ct][4 * gi + 2] += dco * bflo(zw[1]); acc[rt][ct][4 * gi + 3] += dco * bfhi(zw[1]);
        }
    __syncthreads();
#pragma unroll
    for (int rt = 0; rt < 2; ++rt)
#pragma unroll
      for (int ct = 0; ct < 2; ++ct)
#pragma unroll
        for (int gi = 0; gi < 4; ++gi) {
          u32x2 w; w[0] = pack2(acc[rt][ct][4 * gi + 0], acc[rt][ct][4 * gi + 1]); w[1] = pack2(acc[rt][ct][4 * gi + 2], acc[rt][ct][4 * gi + 3]);
          *(u32x2*)(zl + zoff + ct * ctstep * 72 + 32 * rt + 8 * gi) = w;
        }
    __syncthreads();
    {
      const bf16_t* Ug = o == 0 ? Ux1 : Ux2;
      const int gch = o == 0 ? c : 512 + c;
      const float w0 = cw[gch], w1 = cw[1536 + gch], w2 = cw[2 * 1536 + gch], b = cb[gch];
#pragma unroll 1
      for (int n8 = tid; n8 < 2048; n8 += 256) {
        const int n = n8 * 8;
        float g0[4], g1[4];
        sc4(Ug, n, lmask, w0, w1, w2, b, g0);
        sc4(Ug, n + 4, lmask, w0, w1, w2, b, g1);
        bf16_t* zp = zl + ((n >> LSH) * SEQB + PAD + ((n & lmask) >> 6)) * 72 + (n & 63);
        const u32x4 zw = *(const u32x4*)zp;
        float v[8];
        v[0] = g0[0] * bflo(zw[0]); v[1] = g0[1] * bfhi(zw[0]); v[2] = g0[2] * bflo(zw[1]); v[3] = g0[3] * bfhi(zw[1]);
        v[4] = g1[0] * bflo(zw[2]); v[5] = g1[1] * bfhi(zw[2]); v[6] = g1[2] * bflo(zw[3]); v[7] = g1[3] * bfhi(zw[3]);
        if (o == 0) {
          u32x4 w; w[0] = pack2(v[0], v[1]); w[1] = pack2(v[2], v[3]); w[2] = pack2(v[4], v[5]); w[3] = pack2(v[6], v[7]);
          *(u32x4*)zp = w;
        } else {
          const u32x4 gw = *(const u32x4*)(HGc + n);
          u32x4 w;
          w[0] = pack2(v[0] * silu(bflo(gw[0])), v[1] * silu(bfhi(gw[0])));
          w[1] = pack2(v[2] * silu(bflo(gw[1])), v[3] * silu(bfhi(gw[1])));
          w[2] = pack2(v[4] * silu(bflo(gw[2])), v[5] * silu(bfhi(gw[2])));
          w[3] = pack2(v[6] * silu(bflo(gw[3])), v[7] * silu(bfhi(gw[3])));
          *(u32x4*)(HYC + n) = w;
        }
      }
    }
    __syncthreads();
  }
}

DI void final_phase(const Params& p) {
  const int lane = threadIdx.x & 63, wave = __builtin_amdgcn_readfirstlane(threadIdx.x >> 6);
  for (int row = blockIdx.x * 4 + wave; row < NT; row += gridDim.x * 4) {
    float4* xr = (float4*)(p.out + (size_t)row * 1024);
    float4 v[4]; float ss = 0.f;
#pragma unroll
    for (int q = 0; q < 4; ++q) { v[q] = xr[q * 64 + lane]; ss += v[q].x * v[q].x + v[q].y * v[q].y + v[q].z * v[q].z + v[q].w * v[q].w; }
#pragma unroll
    for (int o = 32; o >= 1; o >>= 1) ss += __shfl_xor(ss, o);
    const float rstd = rsqrtf(ss * (1.f / 1024.f) + 1e-6f);
#pragma unroll
    for (int q = 0; q < 4; ++q) {
      const float4 g = ((const float4*)p.final_norm)[q * 64 + lane];
      float4 r; r.x = v[q].x * rstd * g.x; r.y = v[q].y * rstd * g.y; r.z = v[q].z * rstd * g.z; r.w = v[q].w * rstd * g.w;
      xr[q * 64 + lane] = r;
    }
  }
}


DI void run_phase(const Params& p, int ph, char* smem) {
  const int bid = obid(), nbk = gridDim.x;
  if (ph == 0) { prep_phase(p, smem); return; }
  if (ph == NPH - 1) { final_phase(p); return; }
  int q = ph - 1, layer, sub;
  if (q < 3) { layer = 0; sub = q; } else if (q < 15) { layer = 1; sub = q - 3; } else if (q < 18) { layer = 2; sub = q - 15; } else { layer = 3; sub = q - 18; }
  const int li = layer >> 1;
  const float* xcp = layer == 0 ? p.xp : p.out;
  const float* xcs = layer == 0 ? p.xs : p.out + (size_t)16384 * 1024;
  if ((layer & 1) == 0) {
    if (sub == 0) {
      const int ngemm = 640 * 26, nfilt = 5120;
      const bf16_t* Wt = p.wt_ain + (size_t)li * 3328 * 1024;
      gemm_run<1, 0>(p, bid, ngemm, nbk, 26, 0, xcp, xcs, nullptr, Wt, smem);
      for (int j = ngemm + ((bid + nbk - (ngemm % nbk)) % nbk); j < ngemm + nfilt; j += nbk) {
        {
          const int f = j - ngemm;
          if (f < 4096) filt_job(p, li, 0, (f >> 5) & 1, f & 31, f >> 6, smem);
          else { const int f2 = f - 4096; filt_job(p, li, 1, (f2 >> 5) & 1, f2 & 31, f2 >> 6, smem); }
        }
      }
    } else if (sub == 1) {
      const int nhy = 2560, natt = 5120;
      for (int j = bid; j < nhy + natt; j += nbk) {
        if (j < nhy) { const int c_ = j < 512 ? j : (j - 512) >> 2; const int g_ = j < 512 ? 0 : 1 + ((j - 512) & 3);
          if (j < 512) hyena_job<false>(p, li, c_, g_, smem); else hyena_job<true>(p, li, c_, g_, smem); }
        else { for (int rep = 0; rep < REP_ATT; ++rep) attn_even_job(p, li, j - nhy); }
      }
    } else {
      const bf16_t* Wt = p.wt_aout + (size_t)li * 1024 * 1024;
      const bf16_t* A = (const bf16_t*)(p.R + MIX_OFF);
      gemm_run<2, 2>(p, bid, 640 * 8, nbk, 8, 0, xcp, xcs, A, Wt, smem);
    }
  } else {
    const bf16_t* Wi = p.wt_cin + (size_t)li * 10240 * 1024;
    const bf16_t* Wo = p.wt_cout + (size_t)li * 1024 * 1024;
    int c1 = -1, c2 = -1, c3 = -1, c4 = -1;
    if (sub == 0) c1 = 0;
    else if (sub == 1) c2 = 0;
    else {
      const int ch = (sub - 2) >> 1;
      if (((sub - 2) & 1) == 0) { c3 = ch; if (ch < 4) c1 = ch + 1; }
      else { c4 = ch; if (ch < 4) c2 = ch + 1; }
    }
    if (c3 >= 0) merge_phase(p, c3);
    if (c4 >= 0) gemm_run<1, 2>(p, bid, 128 * 8, nbk, 8, c4 * CH, xcp, xcs, (const bf16_t*)(p.R + Y_OFF), Wo, smem);
    if (c1 >= 0) gemm_run<1, 1>(p, bid, 128 * 80, nbk, 80, c1 * CH, xcp, xcs, nullptr, Wi, smem);
    if (c2 >= 0) { for (int j = bid; j < 3072; j += nbk) attn_odd_job(p, c2, j); }
  }
}

#if MULTI_LAUNCH
__global__ void __launch_bounds__(256, 2) phase_kernel(Params p, int ph) {
  __shared__ __attribute__((aligned(16))) char smem[74240];
  run_phase(p, ph, smem);
}
#else
__global__ void __launch_bounds__(256, 2) mega_kernel(Params p) {
  __shared__ __attribute__((aligned(16))) char smem[74240];
  __shared__ uint4 xb_words;
  cg::grid_group grid = cg::this_grid();
  if (threadIdx.x == 0) xb_words = make_uint4(0u, 0u, 0u, 0u);
  __syncthreads();
  XcdBarrier xb = xcd_barrier_post(p.bar, (volatile LAS unsigned*)&xb_words);
#pragma unroll 1
  for (int ph = 0; ph < NPH; ++ph) {
    run_phase(p, ph, smem);
    if (p.bar == nullptr) grid.sync();
    if (ph + 1 < NPH) xcd_barrier(xb);
  }
}
#endif

extern "C" void kernel_launch(void* const* d_in, const int* in_sizes, int n_in, void* d_out, int out_size,
                              void* d_ws, size_t ws_size, hipStream_t stream) {
  Params p{};
  p.xp = (const float*)d_in[0]; p.xs = (const float*)d_in[1];
  p.a_norm = (const float*)d_in[2]; p.a_w_in = (const float*)d_in[3]; p.a_conv_w = (const float*)d_in[4]; p.a_conv_b = (const float*)d_in[5];
  p.fw1 = (const float*)d_in[6]; p.fb1 = (const float*)d_in[7]; p.ff1 = (const float*)d_in[8]; p.fw2 = (const float*)d_in[9];
  p.fb2 = (const float*)d_in[10]; p.ff2 = (const float*)d_in[11]; p.fw3 = (const float*)d_in[12]; p.hyd = (const float*)d_in[13];
  p.sink = (const float*)d_in[14]; p.a_w_out = (const float*)d_in[15]; p.c_norm = (const float*)d_in[16]; p.c_w_in = (const float*)d_in[17];
  p.c_w_out = (const float*)d_in[18]; p.final_norm = (const float*)d_in[19];
  p.out = (float*)d_out;
  char* ws = (char*)d_ws;
  size_t off = 0;
  p.wt_ain = (bf16_t*)(ws + off); off += (size_t)2 * 3328 * 1024 * 2;
  p.wt_cin = (bf16_t*)(ws + off); off += (size_t)2 * 10240 * 1024 * 2;
  p.wt_aout = (bf16_t*)(ws + off); off += (size_t)2 * 1024 * 1024 * 2;
  p.wt_cout = (bf16_t*)(ws + off); off += (size_t)2 * 1024 * 1024 * 2;
  p.hid = (float*)(ws + off); off += (size_t)2 * HID_PER_LAYER * 4;
  p.bar = (unsigned*)(ws + off); off += 16384;
  p.R = ws + off;
  const size_t need = off + (EVEN_END > ODD_END ? EVEN_END : ODD_END);
  if (need > ws_size) { fprintf(stderr, "workspace too small: need %zu have %zu\n", need, ws_size); return; }
#if MULTI_LAUNCH
  for (int ph = 0; ph < NPH; ++ph) hipLaunchKernelGGL(phase_kernel, dim3(1024), dim3(256), 0, stream, p, ph);
#else
  static int grid_blocks = 0;
  if (!grid_blocks) {
    int dev = 0, cus = 0, per_cu = 0;
    (void)hipGetDevice(&dev);
    (void)hipDeviceGetAttribute(&cus, hipDeviceAttributeMultiprocessorCount, dev);
    (void)hipOccupancyMaxActiveBlocksPerMultiprocessor(&per_cu, mega_kernel, 256, 0);
    if (per_cu < 1) per_cu = 1;
    if (per_cu > 2) per_cu = 2;
    grid_blocks = cus * per_cu;
  }
  (void)hipMemsetAsync(p.bar, 0, XCD_BAR_WORDS * 4, stream);
  void* args[] = {&p};
  hipError_t e = hipLaunchCooperativeKernel((void*)mega_kernel, dim3(grid_blocks), dim3(256), args, 0, stream);
  if (e != hipSuccess) fprintf(stderr, "cooperative launch failed: %s (grid %d)\n", hipGetErrorString(e), grid_blocks);
#endif
}
```
